# Optimizing an MI355X kernel written in HIP

```python
import jax, jax.numpy as jnp
from jax import lax
import numpy as np

D_MODEL = 2048
BATCH = 1
SEQ = 8192
DEPTH = 2

HEAD_DIM = 128
SB_HEADS = 6
SB_BLOCK = 128
DIL_GROUPS = ((128, 1), (512, 4), (2048, 16))
DIL_HEADS_PER_GROUP = 2
DIL_HEADS = DIL_HEADS_PER_GROUP * len(DIL_GROUPS)
GLA_HEADS = 4
GLA_DK = 128
GLA_DV = 256
GLA_GATE_RANK = 16
GLA_GATE_TAU = 16.0
GLA_CHUNK = 64
N_BRANCH = 3
D_FF = -(-8 * D_MODEL // (3 * 256)) * 256
N_MOD = 6
EPS = 1e-6

SB_W = SB_HEADS * HEAD_DIM
DIL_W = DIL_HEADS * HEAD_DIM
DIL_OUT_W = DIL_HEADS_PER_GROUP * HEAD_DIM
GLA_QK_W = GLA_HEADS * GLA_DK
GLA_V_W = GLA_HEADS * GLA_DV
IN_SPLITS = (SB_W, SB_W, SB_W, DIL_W, DIL_W, DIL_W, GLA_QK_W, GLA_QK_W, GLA_V_W, GLA_V_W, GLA_GATE_RANK, N_BRANCH * D_MODEL)
IN_WIDTH = sum(IN_SPLITS)

kernel_name = "hybrid_sb_dilated_gla_adaln_block"


def rms_norm(x, gain):
    xf = x.astype(jnp.float32)
    y = xf * lax.rsqrt(jnp.mean(jnp.square(xf), axis=-1, keepdims=True) + EPS)
    return (y * gain.astype(jnp.float32)).astype(x.dtype)


def split_heads(x, n):
    b, t, w = x.shape
    return x.reshape(b, t, n, w // n).transpose(0, 2, 1, 3)


def merge_heads(x):
    b, h, t, d = x.shape
    return x.transpose(0, 2, 1, 3).reshape(b, t, h * d)


def alibi_slopes(n):
    return 2.0 ** (-8.0 * jnp.arange(1, n + 1, dtype=jnp.float32) / n)


def stick_breaking_attention(q, k, v):
    b, h, t, d = q.shape
    scale = d ** -0.5
    outs = []
    for blk in range(t // SB_BLOCK):
        start = blk * SB_BLOCK
        end = start + SB_BLOCK
        qb = q[:, :, start:end]
        kb = k[:, :, :end]
        vb = v[:, :, :end]
        z = jnp.einsum('bhqd,bhkd->bhqk', qb, kb).astype(jnp.float32) * scale
        t_pos = start + jnp.arange(SB_BLOCK)[:, None]
        s_pos = jnp.arange(end)[None, :]
        causal = s_pos < t_pos
        log_beta = jax.nn.log_sigmoid(z)
        log_rest = jnp.where(causal, jax.nn.log_sigmoid(-z), 0.0)
        after = lax.cumsum(log_rest, axis=3, reverse=True) - log_rest
        w = jnp.where(causal, jnp.exp(log_beta + after), 0.0)
        outs.append(jnp.einsum('bhqk,bhkd->bhqd', w.astype(v.dtype), vb))
    return jnp.concatenate(outs, axis=2)


def dilated_group_attention(q, k, v, window, dilation, slopes):
    b, h, t, d = q.shape
    blk = window // dilation
    u_len = t // dilation
    nb = -(-u_len // blk)
    u_pad = nb * blk

    def strided(x):
        x = x.reshape(b, h, u_len, dilation, d).transpose(0, 1, 3, 2, 4)
        x = jnp.pad(x, ((0, 0), (0, 0), (0, 0), (0, u_pad - u_len), (0, 0)))
        return x.reshape(b, h, dilation, nb, blk, d)

    def with_prev(x):
        prev = jnp.pad(x[:, :, :, :-1], ((0, 0), (0, 0), (0, 0), (1, 0), (0, 0), (0, 0)))
        return jnp.concatenate([prev, x], axis=4)

    qs = strided(q)
    kk = with_prev(strided(k))
    vv = with_prev(strided(v))
    s = jnp.einsum('bhrnqd,bhrnkd->bhrnqk', qs, kk).astype(jnp.float32) * (d ** -0.5)
    i = jnp.arange(blk)[:, None]
    j = jnp.arange(2 * blk)[None, :]
    delta = blk + i - j
    n = jnp.arange(nb)[:, None, None]
    valid = (delta >= 0) & (delta <= blk) & (n * blk - blk + j >= 0)
    bias = -(slopes.astype(jnp.float32)[:, None, None] * (dilation * delta).astype(jnp.float32))
    logits = jnp.where(valid, s + bias[None, :, None, None], -jnp.inf)
    lse = jax.nn.logsumexp(logits, axis=-1)
    p = jnp.exp(logits - lse[..., None])
    o = jnp.einsum('bhrnqk,bhrnkd->bhrnqd', p.astype(v.dtype), vv)
    o = o.reshape(b, h, dilation, u_pad, d)[:, :, :, :u_len].transpose(0, 1, 3, 2, 4).reshape(b, h, t, d)
    lse = lse.reshape(b, h, dilation, u_pad)[..., :u_len].transpose(0, 1, 3, 2).reshape(b, h, t)
    return o, lse


def dilated_mixture(q, k, v, slopes):
    outs, lses = [], []
    for g, (window, dilation) in enumerate(DIL_GROUPS):
        sl = slice(g * DIL_HEADS_PER_GROUP, (g + 1) * DIL_HEADS_PER_GROUP)
        o, l = dilated_group_attention(q[:, sl], k[:, sl], v[:, sl], window, dilation, slopes[sl])
        outs.append(o)
        lses.append(l)
    weights = jax.nn.softmax(jnp.stack(lses, axis=0), axis=0)
    mixed = jnp.sum(weights[..., None] * jnp.stack(outs, axis=0).astype(jnp.float32), axis=0)
    return mixed.astype(q.dtype)


def gla_chunked(q, k, v, log_a):
    b, h, t, dk = q.shape
    dv = v.shape[-1]
    c = GLA_CHUNK
    n = t // c

    def chunks(x):
        return x.reshape(b, h, n, c, x.shape[-1]).transpose(2, 0, 1, 3, 4)

    qc = chunks((q.astype(jnp.float32) * (dk ** -0.5)))
    kc = chunks(k.astype(jnp.float32))
    vc = chunks(v.astype(jnp.float32))
    ac = chunks(log_a.astype(jnp.float32))
    mask = jnp.tril(jnp.ones((c, c), dtype=bool))

    def step(state, inp):
        qi, ki, vi, ai = inp
        cum = jnp.cumsum(ai, axis=2)
        inter = jnp.einsum('bhcd,bhde->bhce', qi * jnp.exp(cum), state)
        diff = cum[:, :, :, None, :] - cum[:, :, None, :, :]
        decay = jnp.exp(jnp.where(mask[:, :, None], diff, -jnp.inf))
        scores = jnp.einsum('bhid,bhjd,bhijd->bhij', qi, ki, decay)
        intra = jnp.einsum('bhij,bhje->bhie', scores, vi)
        last = cum[:, :, -1:, :]
        new_state = jnp.exp(last[:, :, 0, :])[..., None] * state + jnp.einsum('bhcd,bhce->bhde', ki * jnp.exp(last - cum), vi)
        return new_state, inter + intra

    s0 = jnp.zeros((b, h, dk, dv), jnp.float32)
    _, o = lax.scan(step, s0, (qc, kc, vc, ac))
    return o.transpose(1, 2, 0, 3, 4).reshape(b, h, t, dv).astype(v.dtype)


def mixing_sublayer(h, w_in, sb_q_gain, sb_k_gain, dil_q_gain, dil_k_gain, w_gla_a, b_gla_a, gla_out_gain,
                    w_br_sb, w_br_dil, w_br_gla, w_out):
    b, t, d = h.shape
    proj = h @ w_in
    idx = [int(i) for i in np.cumsum(IN_SPLITS)[:-1]]
    (q_sb, k_sb, v_sb, q_dil, k_dil, v_dil, q_gla, k_gla, v_gla, r_gla, a_gla, gate_cols) = jnp.split(proj, idx, axis=-1)

    qa = rms_norm(split_heads(q_sb, SB_HEADS), sb_q_gain)
    ka = rms_norm(split_heads(k_sb, SB_HEADS), sb_k_gain)
    o_sb = merge_heads(stick_breaking_attention(qa, ka, split_heads(v_sb, SB_HEADS)))

    qb = rms_norm(split_heads(q_dil, DIL_HEADS), dil_q_gain)
    kb = rms_norm(split_heads(k_dil, DIL_HEADS), dil_k_gain)
    o_dil = merge_heads(dilated_mixture(qb, kb, split_heads(v_dil, DIL_HEADS), alibi_slopes(DIL_HEADS)))

    a = (a_gla @ w_gla_a + b_gla_a).astype(jnp.float32)
    log_a = jax.nn.log_sigmoid(a) / GLA_GATE_TAU
    o_g = gla_chunked(split_heads(q_gla, GLA_HEADS), split_heads(k_gla, GLA_HEADS),
                      split_heads(v_gla, GLA_HEADS), split_heads(log_a, GLA_HEADS))
    o_gla = merge_heads(rms_norm(o_g, gla_out_gain)) * jax.nn.silu(r_gla)

    g = jax.nn.sigmoid(gate_cols.reshape(b, t, N_BRANCH, d))
    y = (g[:, :, 0] * (o_sb @ w_br_sb)
         + g[:, :, 1] * (o_dil @ w_br_dil)
         + g[:, :, 2] * (o_gla @ w_br_gla))
    return y @ w_out


def swiglu(h, w_ffn_in, w_ffn_out):
    gate, up = jnp.split(h @ w_ffn_in, 2, axis=-1)
    return (jax.nn.silu(gate) * up) @ w_ffn_out


def setup_inputs(seed: int = 0) -> dict:
    key = jax.random.key(seed)
    ks = jax.random.split(key, 20)
    L, D = DEPTH, D_MODEL

    def normal(k, shape, scale):
        return jax.random.normal(k, shape, jnp.float32) * scale

    return {
        "x": normal(ks[0], (BATCH, SEQ, D), 1.0),
        "c": normal(ks[1], (BATCH, D), 1.0),
        "w_ada": normal(ks[2], (L, D, N_MOD * D), 0.5 * D ** -0.5),
        "b_ada": normal(ks[3], (L, N_MOD * D), 0.02),
        "norm1_gain": 1.0 + normal(ks[4], (L, D), 0.02),
        "norm2_gain": 1.0 + normal(ks[5], (L, D), 0.02),
        "w_in": normal(ks[6], (L, D, IN_WIDTH), D ** -0.5),
        "sb_q_gain": 1.0 + normal(ks[7], (L, HEAD_DIM), 0.02),
        "sb_k_gain": 1.0 + normal(ks[8], (L, HEAD_DIM), 0.02),
        "dil_q_gain": 1.0 + normal(ks[9], (L, HEAD_DIM), 0.02),
        "dil_k_gain": 1.0 + normal(ks[10], (L, HEAD_DIM), 0.02),
        "w_gla_a": normal(ks[11], (L, GLA_GATE_RANK, GLA_QK_W), GLA_GATE_RANK ** -0.5),
        "b_gla_a": normal(ks[12], (L, GLA_QK_W), 0.02),
        "gla_out_gain": 1.0 + normal(ks[13], (L, GLA_DV), 0.02),
        "w_br_sb": normal(ks[14], (L, SB_W, D), SB_W ** -0.5),
        "w_br_dil": normal(ks[15], (L, DIL_OUT_W, D), DIL_OUT_W ** -0.5),
        "w_br_gla": normal(ks[16], (L, GLA_V_W, D), GLA_V_W ** -0.5),
        "w_out": normal(ks[17], (L, D, D), D ** -0.5),
        "w_ffn_in": normal(ks[18], (L, D, 2 * D_FF), D ** -0.5),
        "w_ffn_out": normal(ks[19], (L, D_FF, D), D_FF ** -0.5),
    }


def reference(x, c, w_ada, b_ada, norm1_gain, norm2_gain, w_in, sb_q_gain, sb_k_gain, dil_q_gain, dil_k_gain,
              w_gla_a, b_gla_a, gla_out_gain, w_br_sb, w_br_dil, w_br_gla, w_out, w_ffn_in, w_ffn_out):
    for l in range(DEPTH):
        mod = jax.nn.silu(c) @ w_ada[l] + b_ada[l]
        shift1, scale1, gate1, shift2, scale2, gate2 = jnp.split(mod[:, None, :], N_MOD, axis=-1)
        h = rms_norm(x, norm1_gain[l]) * (1 + scale1) + shift1
        x = x + gate1 * mixing_sublayer(h, w_in[l], sb_q_gain[l], sb_k_gain[l], dil_q_gain[l], dil_k_gain[l],
                                        w_gla_a[l], b_gla_a[l], gla_out_gain[l],
                                        w_br_sb[l], w_br_dil[l], w_br_gla[l], w_out[l])
        h = rms_norm(x, norm2_gain[l]) * (1 + scale2) + shift2
        x = x + gate2 * swiglu(h, w_ffn_in[l], w_ffn_out[l])
    return x
```

```cpp
#include <hip/hip_runtime.h>
#include <hip/hip_cooperative_groups.h>
#include <cstdio>
namespace cg = cooperative_groups;

#define LAS __attribute__((address_space(3)))
typedef unsigned short bf16_t;
typedef short bf16x8 __attribute__((ext_vector_type(8)));
typedef float f32x4 __attribute__((ext_vector_type(4)));
typedef unsigned u32x4 __attribute__((ext_vector_type(4)));
typedef unsigned u32x2 __attribute__((ext_vector_type(2)));

constexpr int T = 8192, D = 2048, NIN = 13840, NINP = 14080, DFF = 5632;
constexpr int C_QSB = 0, C_KSB = 768, C_VSB = 1536, C_QDIL = 2304, C_KDIL = 3072, C_VDIL = 3840, C_QG = 4608, C_KG = 5120, C_VG = 5632, C_RG = 6656, C_GATE = 7696;
constexpr float EPS = 1e-6f;
constexpr int LDS_BYTES = 143360;

constexpr size_t SZ_WIN = (size_t)NINP * D * 2, SZ_WBS = (size_t)D * 768 * 2, SZ_WBD = (size_t)D * 256 * 2, SZ_WBG = (size_t)D * 1024 * 2,
                 SZ_WOUT = (size_t)D * D * 2, SZ_WFI = (size_t)2 * DFF * D * 2, SZ_WFO = (size_t)D * DFF * 2;
constexpr size_t O_WIN = 0, O_WBR = O_WIN + SZ_WIN  , O_WOUT = O_WBR + SZ_WBS + SZ_WBD + SZ_WBG, O_WFI = O_WOUT + SZ_WOUT,
                 O_WFO = O_WFI + SZ_WFI, SZ_WL = O_WFO + SZ_WFO;
constexpr size_t W_MOD = 2 * SZ_WL;
constexpr size_t W_X = W_MOD + 2 * 12288 * 4;
constexpr size_t W_H = W_X + (size_t)T * D * 4;
constexpr size_t W_PROJ = W_H + (size_t)T * D * 2;
constexpr size_t W_AGLA = W_PROJ + (size_t)T * NINP * 2;
constexpr size_t W_ODG = W_AGLA + (size_t)T * 16 * 4;
constexpr size_t W_LSE = W_ODG + (size_t)3 * T * 256 * 4;
constexpr size_t W_DL = W_LSE + (size_t)3 * 2 * T * 4;
constexpr size_t W_U = W_DL + (size_t)4 * 128 * 128 * 4;
constexpr size_t W_SP = W_U + (size_t)4 * 128 * 32768 * 2;
constexpr size_t W_CUM = W_SP + (size_t)4 * 128 * 32768 * 2;
constexpr size_t W_OCAT = W_CUM + (size_t)T * 512 * 4;
constexpr size_t W_YB = W_OCAT + (size_t)T * D * 2;
constexpr size_t W_BAR = W_YB + (size_t)T * D * 2;
constexpr size_t W_FCNT = W_BAR + 16384;
constexpr size_t W_FSLOT = W_BAR + 65536;
constexpr size_t W_END = W_FSLOT + (size_t)3 * 32 * 256 * 8 * 4;

struct Params {
    const float* in[20];
    float* out;
    unsigned char* ws;
    int ph_lo, ph_hi;
};

typedef __bf16 bf16v2_t __attribute__((ext_vector_type(2)));
typedef float f32v2_t __attribute__((ext_vector_type(2)));
__device__ __forceinline__ unsigned pk2(float lo, float hi) { const f32v2_t v = {lo, hi}; return __builtin_bit_cast(unsigned, __builtin_convertvector(v, bf16v2_t)); }
__device__ __forceinline__ int tidx() { int t = threadIdx.x; asm volatile("" : "+v"(t)); return t; }
__device__ __forceinline__ int bidx() { int b = blockIdx.x; asm volatile("" : "+s"(b)); return b; }
__device__ __forceinline__ float shx(float v, int mask, int lane) { return __int_as_float(__builtin_amdgcn_ds_bpermute((lane ^ mask) << 2, __float_as_int(v))); }
__device__ __forceinline__ unsigned xb_ld(unsigned* p)              { return __hip_atomic_load(p, __ATOMIC_RELAXED, __HIP_MEMORY_SCOPE_AGENT); }
__device__ __forceinline__ unsigned xb_add(unsigned* p, unsigned v) { return __hip_atomic_fetch_add(p, v, __ATOMIC_RELAXED, __HIP_MEMORY_SCOPE_AGENT); }
__device__ __forceinline__ size_t pidx(int row, int col) { return (size_t)(col >> 7) * ((size_t)T * 128) + (size_t)row * 128 + (col & 127); }
__device__ __forceinline__ float bflo(unsigned u) { return __uint_as_float(u << 16); }
__device__ __forceinline__ float bfhi(unsigned u) { return __uint_as_float(u & 0xffff0000u); }
__device__ __forceinline__ float bf1(bf16_t b) { return __uint_as_float(((unsigned)b) << 16); }
__device__ __forceinline__ float sigmoidf_(float x) { return 1.f / (1.f + __expf(-x)); }
__device__ __forceinline__ float sigc(float x) { return __builtin_amdgcn_rcpf(1.f + __expf(-fminf(fmaxf(x, -30.f), 30.f))); }
__device__ __forceinline__ float sigratio(float a, float b) { return (1.f + __expf(-fminf(fmaxf(b, -30.f), 30.f))) * __builtin_amdgcn_rcpf(1.f + __expf(-fminf(fmaxf(a, -30.f), 30.f))); }
__device__ __forceinline__ float siluf_(float x) { return x * __builtin_amdgcn_rcpf(1.f + __expf(-fmaxf(x, -80.f))); }
__device__ __forceinline__ f32x4 mfma16(bf16x8 a, bf16x8 b, f32x4 c) { return __builtin_amdgcn_mfma_f32_16x16x32_bf16(a, b, c, 0, 0, 0); }
__device__ __forceinline__ bf16x8 mk8(unsigned a, unsigned b, unsigned c, unsigned d) { u32x4 v = {a, b, c, d}; return __builtin_bit_cast(bf16x8, v); }

namespace pg8 {
constexpr int BM = 256, BK = 64, HALF = 128, HTB = HALF * BK * 2, STAGE_BYTES = 8 * HTB, NXCD = 8, WGM = 8;
__host__ __device__ __forceinline__ int lds_byte(int r, int c) { const int st = (r >> 4) * 2 + (c >> 5), rr = r & 15, cc = c & 31, ob = rr * 64 + cc * 2; return st * 1024 + (ob ^ (((ob >> 9) & 1) << 5)); }
__host__ __device__ __forceinline__ void stage_rc(int b, int& R, int& C) { const int st = b / 1024, sb = b % 1024, swz = sb ^ (((sb >> 9) & 1) << 5); R = (st >> 1) * 16 + swz / 64; C = (st & 1) * 32 + (swz % 64) / 2; }
__host__ __device__ __forceinline__ int perm32(int rho) { const int n = rho >> 4, i = rho & 15; return 8 * (i >> 2) + 4 * n + (i & 3); }
struct Unit { int pm, pn; };
struct Gemm { const bf16_t* A; const bf16_t* Bt; int M, N, K; };
struct StaticOrder {
    int nM, nN, nwg, G, c;
    __host__ __device__ void init(int M, int N, int G_, int c_) { nM = M / BM; nN = N / BM; nwg = nM * nN; G = G_; c = c_; }
    __host__ __device__ bool next(int i, Unit& u) const {
        const long L = (long)i * G + c; if (L >= nwg) return false;
        int wgid = (int)L; { const int q = nwg / NXCD, r = nwg % NXCD, xcd = wgid % NXCD, off = wgid / NXCD; wgid = (xcd < r ? xcd * (q + 1) : r * (q + 1) + (xcd - r) * q) + off; }
        const int nig = WGM * nN, gid = wgid / nig, fm = gid * WGM, gsz = (nM - fm) < WGM ? (nM - fm) : WGM;
        u.pm = fm + ((wgid % nig) % gsz); u.pn = (wgid % nig) / gsz; return true;
    }
};

template <class Epi>
__device__ __forceinline__ void gemm_phase(LAS unsigned char* lds, const Gemm g, const StaticOrder& S, const Epi& E) {
    const int tid = tidx(), wid = __builtin_amdgcn_readfirstlane(tid >> 6), lane = tid & 63, wr = wid >> 2, wc = wid & 3, fr = lane & 15, fq = lane >> 4;
    const int K = g.K, nt = K / BK;
    unsigned voffA[2], voffB[2];
#pragma unroll
    for (int i = 0; i < 2; ++i) { int R, C; stage_rc(tid * 16 + i * 8192, R, C); const int Rb = E.PERM ? ((R & ~31) + perm32(R & 31)) : R;
        voffA[i] = (unsigned)(R * K + C) * 2u; voffB[i] = (unsigned)(Rb * K + C) * 2u; }
    const size_t kstep = (size_t)(BK * 2);
    const size_t hstep = (size_t)HALF * K * 2;
    const size_t tstep = 2 * hstep;
    const unsigned ldsw = (unsigned)wid * 1024u;
    const int aoff = lds_byte(wr * 64 + fr, fq * 8), boff = lds_byte(wc * 32 + fr, fq * 8);
#define PG8_SA(b, h) (((b) * 2 + (h)) * HTB)
#define PG8_SB(b, h) ((4 + (b) * 2 + (h)) * HTB)
#define PG8_STAGE(bufoff, gbase, voff) do { _Pragma("unroll") for (int _i = 0; _i < 2; ++_i) \
        __builtin_amdgcn_global_load_lds((const unsigned*)((const char*)(gbase) + (voff)[_i]), (LAS unsigned*)(lds + (bufoff) + ldsw + _i * 8192), 16, 0, 0); } while (0)
#define PG8_LDA(dst, b, h) do { _Pragma("unroll") for (int m = 0; m < 4; ++m) _Pragma("unroll") for (int k = 0; k < 2; ++k) dst[m][k] = *(const LAS bf16x8*)(lds + PG8_SA(b, h) + aoff + m * 2048 + k * 1024); } while (0)
#define PG8_LDB(dst, b, h) do { _Pragma("unroll") for (int n = 0; n < 2; ++n) _Pragma("unroll") for (int k = 0; k < 2; ++k) dst[n][k] = *(const LAS bf16x8*)(lds + PG8_SB(b, h) + boff + n * 2048 + k * 1024); } while (0)
#define PG8_MMA(ai, bj, At, Bt) do { __builtin_amdgcn_s_setprio(1); _Pragma("unroll") for (int m = 0; m < 4; ++m) _Pragma("unroll") for (int n = 0; n < 2; ++n) _Pragma("unroll") for (int k = 0; k < 2; ++k) \
        acc[ai][bj][m][n] = __builtin_amdgcn_mfma_f32_16x16x32_bf16(Bt[n][k], At[m][k], acc[ai][bj][m][n], 0, 0, 0); __builtin_amdgcn_s_setprio(0); } while (0)
#define PG8_WAIT_V(n) asm volatile("s_waitcnt vmcnt(" #n ")" ::: "memory")
#define PG8_WAIT_L(n) asm volatile("s_waitcnt lgkmcnt(" #n ")" ::: "memory")
#define PG8_BAR __builtin_amdgcn_s_barrier()
#define PG8_SCHED __builtin_amdgcn_sched_barrier(0)
    Unit cur, nxt; int ui = 0;
    if (!S.next(0, cur)) return;
    f32x4 acc[2][2][4][2];
#pragma unroll
    for (int a = 0; a < 2; ++a)
#pragma unroll
        for (int b = 0; b < 2; ++b)
#pragma unroll
            for (int m = 0; m < 4; ++m)
#pragma unroll
                for (int n = 0; n < 2; ++n) acc[a][b][m][n] = (f32x4){0.f, 0.f, 0.f, 0.f};
    bf16x8 At[4][2], B0[2][2], B1[2][2];
    const char* cA = (const char*)g.A + (size_t)cur.pm * tstep; const char* cB = (const char*)g.Bt + (size_t)cur.pn * tstep;
    PG8_STAGE(PG8_SB(0, 0), cB, voffB); PG8_STAGE(PG8_SA(0, 0), cA, voffA); PG8_STAGE(PG8_SB(0, 1), cB + hstep, voffB); PG8_STAGE(PG8_SA(0, 1), cA + hstep, voffA);
    if (wr == 1) PG8_BAR;
    PG8_WAIT_V(4); PG8_BAR;
    PG8_STAGE(PG8_SB(1, 0), cB + kstep, voffB); PG8_STAGE(PG8_SA(1, 0), cA + kstep, voffA); PG8_STAGE(PG8_SB(1, 1), cB + hstep + kstep, voffB);
    PG8_WAIT_V(6); PG8_BAR;
    for (;;) {
        const bool has_next = S.next(ui + 1, nxt);
        const char* nA = has_next ? (const char*)g.A + (size_t)nxt.pm * tstep : cA; const char* nB = has_next ? (const char*)g.Bt + (size_t)nxt.pn * tstep : cB;
        int t = 0;
#pragma unroll 1
        for (int seg = 0; seg < 3; ++seg) {
        const int tend = (E.mode == 1) ? (seg == 0 ? 12 : (seg == 1 ? 16 : nt)) : (seg == 0 ? nt : 0);
#pragma unroll 1
        for (; t < tend; t += 2) {
            const bool last = (t == nt - 2);
            const char* a1 = cA + (size_t)(t + 1) * kstep;
            const char* a2 = last ? nA : cA + (size_t)(t + 2) * kstep; const char* b2 = last ? nB : cB + (size_t)(t + 2) * kstep;
            const char* a3 = a2 + kstep; const char* b3 = b2 + kstep;
            PG8_LDB(B0, 0, 0); PG8_SCHED; PG8_LDA(At, 0, 0); PG8_STAGE(PG8_SA(1, 1), a1 + hstep, voffA);
            PG8_WAIT_L(8); PG8_BAR; PG8_WAIT_L(0); PG8_MMA(0, 0, At, B0); PG8_BAR; PG8_SCHED;
            PG8_LDB(B1, 0, 1); PG8_STAGE(PG8_SB(0, 0), b2, voffB);
            PG8_BAR; PG8_WAIT_L(0); PG8_MMA(0, 1, At, B1); PG8_BAR;
            PG8_LDA(At, 0, 1); PG8_STAGE(PG8_SA(0, 0), a2, voffA);
            PG8_BAR; PG8_WAIT_L(0); PG8_MMA(1, 0, At, B0); PG8_BAR; PG8_SCHED;
            PG8_STAGE(PG8_SB(0, 1), b2 + hstep, voffB);
            PG8_WAIT_V(6); PG8_BAR; PG8_MMA(1, 1, At, B1); PG8_BAR;
            PG8_LDB(B0, 1, 0); PG8_SCHED; PG8_LDA(At, 1, 0); PG8_STAGE(PG8_SA(0, 1), a2 + hstep, voffA);
            PG8_WAIT_L(8); PG8_BAR; PG8_WAIT_L(0); PG8_MMA(0, 0, At, B0); PG8_BAR; PG8_SCHED;
            PG8_LDB(B1, 1, 1); PG8_STAGE(PG8_SB(1, 0), b3, voffB);
            PG8_BAR; PG8_WAIT_L(0); PG8_MMA(0, 1, At, B1); PG8_BAR;
            PG8_LDA(At, 1, 1); PG8_STAGE(PG8_SA(1, 0), a3, voffA);
            PG8_BAR; PG8_WAIT_L(0); PG8_MMA(1, 0, At, B0); PG8_BAR; PG8_SCHED;
            PG8_STAGE(PG8_SB(1, 1), b3 + hstep, voffB);
            PG8_WAIT_V(6); PG8_BAR; PG8_MMA(1, 1, At, B1); PG8_BAR;
        }
        if (E.mode == 1 && seg < 2) E.hook(acc, cur, wr, wc, fr, fq, seg);
        }
        if (!E.fuse) E(acc, cur, wr, wc, fr, fq);
        if (!has_next) break;
#pragma unroll
        for (int a = 0; a < 2; ++a)
#pragma unroll
            for (int b = 0; b < 2; ++b)
#pragma unroll
                for (int m = 0; m < 4; ++m)
#pragma unroll
                    for (int n = 0; n < 2; ++n) acc[a][b][m][n] = (f32x4){0.f, 0.f, 0.f, 0.f};
        cur = nxt; cA = nA; cB = nB; ++ui;
    }
    PG8_WAIT_V(0);
    if (wr == 0) PG8_BAR;
    PG8_BAR;
    if (E.fuse) E.fused(acc, cur, wr, wc, fr, fq, (unsigned char*)lds);
#undef PG8_SA
#undef PG8_SB
#undef PG8_STAGE
#undef PG8_LDA
#undef PG8_LDB
#undef PG8_MMA
#undef PG8_WAIT_V
#undef PG8_WAIT_L
#undef PG8_BAR
#undef PG8_SCHED
}
}

struct EpiAny {
    int mode; bool PERM;
    int l; const Params& p; bool fuse;
#define EPI_SETUP() int ll = l; asm volatile("" : "+s"(ll)); unsigned char* const ws = p.ws; bf16_t* const P = (bf16_t*)(ws + W_PROJ); (void)P; \
        const float* const MOD = (const float*)(ws + W_MOD) + ll * 12288; (void)MOD; float* const X = (float*)(ws + W_X); (void)X
    __device__ __forceinline__ void hook(f32x4 (&acc)[2][2][4][2], const pg8::Unit& u, int wr, int wc, int fr, int fq, int which) const {
        EPI_SETUP();
        int row0 = u.pm * 256 + wr * 64 + fr; asm volatile("" : "+v"(row0));
        const int col0 = u.pn * 256 + wc * 32 + 8 * fq;
        const int gc0 = C_GATE + which * 2048 + col0;
        u32x4 gb[2][2][2];
#define HOOK_LD(it, bf) do { const int gr = row0 + ((it) >> 2) * 128 + ((it) & 3) * 16; \
        _Pragma("unroll") for (int bj = 0; bj < 2; ++bj) { gb[bf][bj][0] = *(const u32x4*)(P + pidx(gr, gc0 + bj * 128)); gb[bf][bj][1] = *(const u32x4*)(P + pidx(gr, gc0 + 2048 + bj * 128)); } } while (0)
        HOOK_LD(0, 0);
#pragma unroll
        for (int it = 0; it < 8; ++it) {
            if (it < 7) HOOK_LD(it + 1, (it + 1) & 1);
            const int ai = it >> 2, m = it & 3;
#pragma unroll
            for (int bj = 0; bj < 2; ++bj) {
                const u32x4 ga = gb[it & 1][bj][0], gq = gb[it & 1][bj][1];
#pragma unroll
                for (int n = 0; n < 2; ++n) {
                    f32x4 r = {sigratio(bflo(ga[2 * n]), bflo(gq[2 * n])), sigratio(bfhi(ga[2 * n]), bfhi(gq[2 * n])), sigratio(bflo(ga[2 * n + 1]), bflo(gq[2 * n + 1])), sigratio(bfhi(ga[2 * n + 1]), bfhi(gq[2 * n + 1]))};
                    acc[ai][bj][m][n] *= r;
                }
            }
            asm volatile("" ::: "memory");
        }
#undef HOOK_LD
    }
    __device__ __forceinline__ void fused(f32x4 (&acc)[2][2][4][2], const pg8::Unit& u, int wr, int wc, int fr, int fq, unsigned char* lds) const {
        EPI_SETUP();
        const int tid = tidx(), lane = tid & 63;
        int row0 = u.pm * 256 + wr * 64 + fr; asm volatile("" : "+v"(row0));
        const int col0 = u.pn * 256 + wc * 32 + 8 * fq;
        const float* const xin = (mode == 4 && ll == 0) ? p.in[0] : X;
        const float* const gate = MOD + (mode == 4 ? 4096 : 10240);
        const int site = mode == 4 ? ll : 2;
        const float* const ngain = mode == 4 ? p.in[5] + ll * D : p.in[4] + D;
        const float* const nshift = mode == 4 ? MOD + 6144 : MOD + 12288;
        const float* const nscale = mode == 4 ? MOD + 8192 : MOD + 12288 + 2048;
        float* tab = (float*)lds; float* invtab = (float*)(lds + 4096);
        f32x4 gv[2][2], xb[2][2][2];
#pragma unroll
        for (int bj = 0; bj < 2; ++bj)
#pragma unroll
            for (int n = 0; n < 2; ++n) gv[bj][n] = *(const f32x4*)(gate + col0 + bj * 128 + n * 4);
#define F4_LD(it, bf) do { const float* xp = xin + (size_t)(row0 + ((it) >> 2) * 128 + ((it) & 3) * 16) * D + col0; \
        _Pragma("unroll") for (int bj = 0; bj < 2; ++bj) _Pragma("unroll") for (int n = 0; n < 2; ++n) xb[bf][bj][n] = *(const f32x4*)(xp + bj * 128 + n * 4); } while (0)
        F4_LD(0, 0);
#pragma unroll
        for (int it = 0; it < 8; ++it) {
            if (it < 7) F4_LD(it + 1, (it + 1) & 1);
            const int ai = it >> 2, m = it & 3;
            float* op = X + (size_t)(row0 + ai * 128 + m * 16) * D + col0;
            float ps = 0.f;
#pragma unroll
            for (int bj = 0; bj < 2; ++bj)
#pragma unroll
                for (int n = 0; n < 2; ++n) {
                    const f32x4 xv = xb[it & 1][bj][n] + gv[bj][n] * acc[ai][bj][m][n];
                    *(f32x4*)(op + bj * 128 + n * 4) = xv;
                    acc[ai][bj][m][n] = xv;
                    ps += xv[0] * xv[0] + xv[1] * xv[1] + xv[2] * xv[2] + xv[3] * xv[3];
                }
            ps += shx(ps, 16, lane); ps += shx(ps, 32, lane);
            if (fq == 0) tab[(ai * 128 + wr * 64 + m * 16 + fr) * 4 + wc] = ps;
            asm volatile("" ::: "memory");
        }
#undef F4_LD
        __syncthreads();
        unsigned* const cnt = (unsigned*)(ws + W_FCNT) + (site * 32 + u.pm) * 64;
        unsigned* const slot = (unsigned*)(ws + W_FSLOT) + ((size_t)(site * 32 + u.pm) * 256) * 8;
        if (tid < 256) {
            const f32x4 t4 = *(const f32x4*)(tab + tid * 4);
            __hip_atomic_store(slot + tid * 8 + u.pn, __float_as_uint(t4[0] + t4[1] + t4[2] + t4[3]), __ATOMIC_RELAXED, __HIP_MEMORY_SCOPE_AGENT);
        }
        asm volatile("s_waitcnt vmcnt(0)" ::: "memory");
        __syncthreads();
        if (tid == 0) {
            (void)xb_add(cnt, 1u);
            unsigned sp_ = 0;
            while (xb_ld(cnt) < 8u) { __builtin_amdgcn_s_sleep(1); if (++sp_ > (1u << 22)) break; }
        }
        __syncthreads();
        if (tid < 256) {
            float sum = 0.f;
#pragma unroll
            for (int j = 0; j < 8; ++j) sum += __uint_as_float(xb_ld(slot + tid * 8 + j));
            invtab[tid] = rsqrtf(sum * (1.f / D) + EPS);
        }
        __syncthreads();
        bf16_t* const H = (bf16_t*)(ws + W_H);
        f32x4 cmv[2][2], shv[2][2];
#pragma unroll
        for (int bj = 0; bj < 2; ++bj)
#pragma unroll
            for (int n = 0; n < 2; ++n) {
                const int c = col0 + bj * 128 + n * 4;
                cmv[bj][n] = *(const f32x4*)(ngain + c) * (1.f + *(const f32x4*)(nscale + c)); shv[bj][n] = *(const f32x4*)(nshift + c);
            }
#pragma unroll
        for (int it = 0; it < 8; ++it) {
            const int ai = it >> 2, m = it & 3;
            const float inv = invtab[ai * 128 + wr * 64 + m * 16 + fr];
            bf16_t* hp = H + (size_t)(row0 + ai * 128 + m * 16) * D + col0;
#pragma unroll
            for (int bj = 0; bj < 2; ++bj) {
                const f32x4 y0 = acc[ai][bj][m][0] * inv * cmv[bj][0] + shv[bj][0], y1 = acc[ai][bj][m][1] * inv * cmv[bj][1] + shv[bj][1];
                u32x4 o = {pk2(y0[0], y0[1]), pk2(y0[2], y0[3]), pk2(y1[0], y1[1]), pk2(y1[2], y1[3])};
                *(u32x4*)(hp + bj * 128) = o;
            }
        }
    }
    __device__ __forceinline__ void operator()(const f32x4 (&acc)[2][2][4][2], const pg8::Unit& u, int wr, int wc, int fr, int fq) const {
        EPI_SETUP();
        int row0 = u.pm * 256 + wr * 64 + fr; asm volatile("" : "+v"(row0));
        if (mode == 0) {
            float* const agla = (float*)(ws + W_AGLA);
            const int col0 = u.pn * 256 + wc * 32 + 8 * fq;
#pragma unroll
            for (int ai = 0; ai < 2; ++ai)
#pragma unroll
                for (int m = 0; m < 4; ++m) {
                    const int row = row0 + ai * 128 + m * 16;
                    bf16_t* rp = P + pidx(row, col0);
#pragma unroll
                    for (int bj = 0; bj < 2; ++bj) {
                        const f32x4 v0 = acc[ai][bj][m][0], v1 = acc[ai][bj][m][1];
                        u32x4 o = {pk2(v0[0], v0[1]), pk2(v0[2], v0[3]), pk2(v1[0], v1[1]), pk2(v1[2], v1[3])};
                        if (u.pn >= 31) __builtin_nontemporal_store(o, (u32x4*)(rp + (size_t)bj * T * 128));
                        else *(u32x4*)(rp + (size_t)bj * T * 128) = o;
                    }
                    if (u.pn == 30 && wc == 0 && fq < 2) { float* a = agla + (size_t)row * 16 + 8 * fq; *(f32x4*)a = acc[ai][0][m][0]; *(f32x4*)(a + 4) = acc[ai][0][m][1]; }
                }
        } else if (mode == 1) {
            bf16_t* const YB = (bf16_t*)(ws + W_YB);
            const int col0 = u.pn * 256 + wc * 32 + 8 * fq;
            const int gc2 = C_GATE + 4096 + col0;
            u32x4 gb[2][2];
#define M1_LD(it, bf) do { const int gr = row0 + ((it) >> 2) * 128 + ((it) & 3) * 16; \
            _Pragma("unroll") for (int bj = 0; bj < 2; ++bj) gb[bf][bj] = *(const u32x4*)(P + pidx(gr, gc2 + bj * 128)); } while (0)
            M1_LD(0, 0);
#pragma unroll
            for (int it = 0; it < 8; ++it) {
                if (it < 7) M1_LD(it + 1, (it + 1) & 1);
                const int ai = it >> 2, m = it & 3, row = row0 + ai * 128 + m * 16;
#pragma unroll
                for (int bj = 0; bj < 2; ++bj) {
                    const u32x4 gw = gb[it & 1][bj];
                    const f32x4 a0 = acc[ai][bj][m][0], a1 = acc[ai][bj][m][1];
                    u32x4 o = {pk2(sigc(bflo(gw[0])) * a0[0], sigc(bfhi(gw[0])) * a0[1]), pk2(sigc(bflo(gw[1])) * a0[2], sigc(bfhi(gw[1])) * a0[3]),
                               pk2(sigc(bflo(gw[2])) * a1[0], sigc(bfhi(gw[2])) * a1[1]), pk2(sigc(bflo(gw[3])) * a1[2], sigc(bfhi(gw[3])) * a1[3])};
                    *(u32x4*)(YB + (size_t)row * D + col0 + bj * 128) = o;
                }
                asm volatile("" ::: "memory");
            }
#undef M1_LD
        } else if (mode == 4 || mode == 6) {
            const float* const xin = (mode == 4 && ll == 0) ? p.in[0] : X;
            const float* const gate = MOD + (mode == 4 ? 4096 : 10240);
            float* const out = (mode == 6 && ll == 1) ? p.out : X;
            const int col0 = u.pn * 256 + wc * 32 + 8 * fq;
            f32x4 gv[2][2], xb[2][2][2];
#pragma unroll
            for (int bj = 0; bj < 2; ++bj)
#pragma unroll
                for (int n = 0; n < 2; ++n) gv[bj][n] = *(const f32x4*)(gate + col0 + bj * 128 + n * 4);
#define M4_LD(it, bf) do { const float* xp = xin + (size_t)(row0 + ((it) >> 2) * 128 + ((it) & 3) * 16) * D + col0; \
            _Pragma("unroll") for (int bj = 0; bj < 2; ++bj) _Pragma("unroll") for (int n = 0; n < 2; ++n) xb[bf][bj][n] = *(const f32x4*)(xp + bj * 128 + n * 4); } while (0)
            M4_LD(0, 0);
#pragma unroll
            for (int it = 0; it < 8; ++it) {
                if (it < 7) M4_LD(it + 1, (it + 1) & 1);
                const int ai = it >> 2, m = it & 3;
                float* op = out + (size_t)(row0 + ai * 128 + m * 16) * D + col0;
#pragma unroll
                for (int bj = 0; bj < 2; ++bj)
#pragma unroll
                    for (int n = 0; n < 2; ++n) { const f32x4 xo = xb[it & 1][bj][n] + gv[bj][n] * acc[ai][bj][m][n]; if (out == p.out) __builtin_nontemporal_store(xo, (f32x4*)(op + bj * 128 + n * 4)); else *(f32x4*)(op + bj * 128 + n * 4) = xo; }
                asm volatile("" ::: "memory");
            }
#undef M4_LD
        } else {
            const int col0 = u.pn * 128 + wc * 32 + 8 * fq;
#pragma unroll
            for (int ai = 0; ai < 2; ++ai)
#pragma unroll
                for (int m = 0; m < 4; ++m) {
                    const int row = row0 + ai * 128 + m * 16;
                    float h[8];
#pragma unroll
                    for (int n = 0; n < 2; ++n)
#pragma unroll
                        for (int j = 0; j < 4; ++j) h[n * 4 + j] = siluf_(acc[ai][0][m][n][j]) * acc[ai][1][m][n][j];
                    u32x4 o = {pk2(h[0], h[1]), pk2(h[2], h[3]), pk2(h[4], h[5]), pk2(h[6], h[7])};
                    *(u32x4*)(P + (size_t)row * DFF + col0) = o;
                }
        }
    }
};

__device__ __forceinline__ void mod_item(const Params& p, int item, unsigned char* lds) {
    const int tid = tidx();
    float* sc = (float*)lds; float* part = (float*)(lds + 8192);
    const int l = item >> 7, j0 = (item & 127) * 96;
    const float* c = p.in[1]; const float* w = p.in[2] + (size_t)l * D * 12288; const float* b = p.in[3] + l * 12288;
    float* MOD = (float*)(p.ws + W_MOD);
    for (int i = tid; i < D; i += 512) { const float v = c[i]; sc[i] = siluf_(v); }
    __syncthreads();
    const int cgp = tid % 24, ks = tid / 24;
    if (ks < 21) {
        f32x4 a = {0.f, 0.f, 0.f, 0.f};
#pragma unroll 8
        for (int k = ks; k < D; k += 21) { const f32x4 wv = __builtin_nontemporal_load((const f32x4*)(w + (size_t)k * 12288 + j0 + cgp * 4)); a += sc[k] * wv; }
        *(f32x4*)(part + ks * 96 + cgp * 4) = a;
    }
    __syncthreads();
    if (tid < 96) { float s = b[j0 + tid]; for (int q = 0; q < 21; ++q) s += part[q * 96 + tid]; MOD[l * 12288 + j0 + tid] = s; }
    __syncthreads();
}

struct ConvDesc { const float* src; bf16_t* dst; int Nsrc, nvalid, K; };
constexpr int CV_PER_LAYER = 4384;
__device__ __forceinline__ ConvDesc conv_desc(const Params& p, int item) {
    const int l = item / CV_PER_LAYER; int r = item % CV_PER_LAYER;
    unsigned char* wl = p.ws + (size_t)l * SZ_WL;
    ConvDesc d; d.nvalid = 128;
    if (r < 1760) { const int kt = r / 110, nt = r % 110; int nv = NIN - nt * 128; d.nvalid = nv < 0 ? 0 : (nv > 128 ? 128 : nv); d.Nsrc = NIN; d.K = D;
        d.src = p.in[6] + (size_t)l * D * NIN + (size_t)(kt * 128) * NIN + nt * 128; d.dst = (bf16_t*)(wl + O_WIN) + (size_t)(nt * 128) * D + kt * 128; return d; }
    r -= 1760;
    if (r < 96) { const int kt = r >> 4, nt = r & 15; d.Nsrc = D; d.K = D;
        d.src = p.in[14] + (size_t)l * 768 * D + (size_t)(kt * 128) * D + nt * 128; d.dst = (bf16_t*)(wl + O_WBR) + (size_t)(nt * 128) * D + kt * 128; return d; }
    r -= 96;
    if (r < 32) { const int kt = r >> 4, nt = r & 15; d.Nsrc = D; d.K = D;
        d.src = p.in[15] + (size_t)l * 256 * D + (size_t)(kt * 128) * D + nt * 128; d.dst = (bf16_t*)(wl + O_WBR) + (size_t)(nt * 128) * D + 768 + kt * 128; return d; }
    r -= 32;
    if (r < 128) { const int kt = r >> 4, nt = r & 15; d.Nsrc = D; d.K = D;
        d.src = p.in[16] + (size_t)l * 1024 * D + (size_t)(kt * 128) * D + nt * 128; d.dst = (bf16_t*)(wl + O_WBR) + (size_t)(nt * 128) * D + 1024 + kt * 128; return d; }
    r -= 128;
    if (r < 256) { const int kt = r >> 4, nt = r & 15; d.Nsrc = D; d.K = D;
        d.src = p.in[17] + (size_t)l * D * D + (size_t)(kt * 128) * D + nt * 128; d.dst = (bf16_t*)(wl + O_WOUT) + (size_t)(nt * 128) * D + kt * 128; return d; }
    r -= 256;
    if (r < 1408) { const int kt = r / 88, nt = r % 88; const int pn = nt >> 1, bj = nt & 1; d.Nsrc = 2 * DFF; d.K = D;
        d.src = p.in[18] + (size_t)l * D * 2 * DFF + (size_t)(kt * 128) * (2 * DFF) + bj * DFF + pn * 128; d.dst = (bf16_t*)(wl + O_WFI) + (size_t)(nt * 128) * D + kt * 128; return d; }
    r -= 1408;
    { const int kt = r >> 4, nt = r & 15; d.Nsrc = D; d.K = DFF;
      d.src = p.in[19] + (size_t)l * DFF * D + (size_t)(kt * 128) * D + nt * 128; d.dst = (bf16_t*)(wl + O_WFO) + (size_t)(nt * 128) * DFF + kt * 128; return d; }
}
__device__ __forceinline__ void conv_load(const ConvDesc& d, int tid, f32x4 (&v)[8]) {
#pragma unroll
    for (int i = 0; i < 8; ++i) {
        const int idx = tid + 512 * i, row = idx >> 5, c4 = idx & 31;
        v[i] = (f32x4){0.f, 0.f, 0.f, 0.f};
        if (c4 * 4 < d.nvalid) v[i] = __builtin_nontemporal_load((const f32x4*)(d.src + (size_t)row * d.Nsrc + c4 * 4));
    }
}
__device__ __forceinline__ void conv_phase(const Params& p, unsigned char* lds, int lo1, int n1, int lo2, int n2, int worker, int nworkers) {
    const int tid = tidx(), lane = tid & 63, w = tid >> 6;
    float* st = (float*)lds;
    const int ntot = n1 + n2;
    int v = worker;
    if (v >= ntot) return;
    ConvDesc d = conv_desc(p, v < n1 ? lo1 + v : lo2 + v - n1);
    f32x4 x4[8];
    conv_load(d, tid, x4);
    for (;;) {
#pragma unroll
        for (int i = 0; i < 8; ++i) {
            const int idx = tid + 512 * i; float* sp = st + (idx >> 5) * 129 + (idx & 31) * 4;
            sp[0] = x4[i][0]; sp[1] = x4[i][1]; sp[2] = x4[i][2]; sp[3] = x4[i][3];
        }
        __syncthreads();
        const ConvDesc dc = d;
        const int nx = v + nworkers; const bool more = nx < ntot;
        if (more) { d = conv_desc(p, nx < n1 ? lo1 + nx : lo2 + nx - n1); conv_load(d, tid, x4); }
        unsigned* dp = (unsigned*)(dc.dst + (size_t)(16 * w) * dc.K) + lane;
        const float* rp = st + (2 * lane) * 129 + 16 * w;
#pragma unroll
        for (int q = 0; q < 16; ++q) dp[(size_t)q * (dc.K >> 1)] = pk2(rp[q], rp[129 + q]);
        __syncthreads();
        if (!more) break;
        v = nx;
    }
}
constexpr int CV_DEF_A = 256, CV_DEF_B = 1280, CV_DEF_C = 3680, CV_DEF_D = 3936;

__device__ __forceinline__ void norm_phase(const float* __restrict__ xin, const float* __restrict__ gain, const float* __restrict__ shift, const float* __restrict__ scale, bf16_t* __restrict__ H) {
    const int tid = tidx(), lane = tid & 63, gw = bidx() * 8 + (tid >> 6), nw = gridDim.x * 8;
    for (int row = gw; row < T; row += nw) {
        const float* xr = xin + (size_t)row * D;
        f32x4 v[8]; float ss = 0.f;
#pragma unroll
        for (int i = 0; i < 8; ++i) { v[i] = *(const f32x4*)(xr + i * 256 + lane * 4); ss += v[i][0] * v[i][0] + v[i][1] * v[i][1] + v[i][2] * v[i][2] + v[i][3] * v[i][3]; }
#pragma unroll
        for (int o = 32; o > 0; o >>= 1) ss += shx(ss, o, lane);
        const float inv = rsqrtf(ss * (1.f / D) + EPS);
#pragma unroll
        for (int i = 0; i < 8; ++i) {
            const int c = i * 256 + lane * 4;
            const f32x4 g = *(const f32x4*)(gain + c), sh = *(const f32x4*)(shift + c), sc = *(const f32x4*)(scale + c);
            const f32x4 y = v[i] * inv * g * (1.f + sc) + sh;
            u32x2 o = {pk2(y[0], y[1]), pk2(y[2], y[3])};
            *(u32x2*)(H + (size_t)row * D + c) = o;
        }
    }
}

template <int nkeys> __device__ __forceinline__ void stage_vt(bf16_t* VT, int pitch, const bf16_t* P, int r0, int rstride, int col, int nch) {
    const int tid = tidx();
    for (int idx = tid; idx < nkeys * nch; idx += 512) {
        const int key = idx % nkeys, ch = idx / nkeys;
        const u32x4 raw = *(const u32x4*)(P + pidx(r0 + key * rstride, col + ch * 8));
        bf16_t* d = VT + (ch * 8) * pitch + key;
        d[0] = (bf16_t)(raw[0] & 0xffff); d[pitch] = (bf16_t)(raw[0] >> 16); d[2 * pitch] = (bf16_t)(raw[1] & 0xffff); d[3 * pitch] = (bf16_t)(raw[1] >> 16);
        d[4 * pitch] = (bf16_t)(raw[2] & 0xffff); d[5 * pitch] = (bf16_t)(raw[2] >> 16); d[6 * pitch] = (bf16_t)(raw[3] & 0xffff); d[7 * pitch] = (bf16_t)(raw[3] >> 16);
    }
}
__device__ __forceinline__ void stage_rows128_norm(bf16_t* dst, const bf16_t* P, int r0, int rstride, int col, const float* __restrict__ gain, float qs) {
    const int tid = tidx(), lane = tid & 63;
    const f32x4 g0 = *(const f32x4*)(gain + (tid & 15) * 8), g1 = *(const f32x4*)(gain + (tid & 15) * 8 + 4);
#pragma unroll
    for (int i = 0; i < 4; ++i) {
        const int idx = tid + 512 * i, r = idx >> 4, ch = idx & 15;
        const u32x4 raw = *(const u32x4*)(P + pidx(r0 + r * rstride, col + ch * 8));
        float v[8] = {bflo(raw[0]), bfhi(raw[0]), bflo(raw[1]), bfhi(raw[1]), bflo(raw[2]), bfhi(raw[2]), bflo(raw[3]), bfhi(raw[3])};
        float ss = 0.f;
#pragma unroll
        for (int j = 0; j < 8; ++j) ss += v[j] * v[j];
        ss += shx(ss, 1, lane); ss += shx(ss, 2, lane); ss += shx(ss, 4, lane); ss += shx(ss, 8, lane);
        const float inv = rsqrtf(ss * (1.f / 128.f) + EPS) * qs;
        u32x4 o = {pk2(v[0] * inv * g0[0], v[1] * inv * g0[1]), pk2(v[2] * inv * g0[2], v[3] * inv * g0[3]),
                   pk2(v[4] * inv * g1[0], v[5] * inv * g1[1]), pk2(v[6] * inv * g1[2], v[7] * inv * g1[3])};
        *(u32x4*)(dst + r * 136 + ch * 8) = o;
    }
}
__device__ __forceinline__ void pv_tile(f32x4 (&oacc)[8], const bf16_t* VT, int pitch, int koff, const float (&w)[4][4], int fr, int fq) {
    bf16x8 pf[2];
#pragma unroll
    for (int kb = 0; kb < 2; ++kb) pf[kb] = mk8(pk2(w[2 * kb][0], w[2 * kb][1]), pk2(w[2 * kb][2], w[2 * kb][3]), pk2(w[2 * kb + 1][0], w[2 * kb + 1][1]), pk2(w[2 * kb + 1][2], w[2 * kb + 1][3]));
#pragma unroll
    for (int db = 0; db < 8; ++db)
#pragma unroll
        for (int kb = 0; kb < 2; ++kb) {
            const bf16_t* vp = VT + (16 * db + fr) * pitch + koff + 32 * kb + 4 * fq;
            const u32x2 lo = *(const u32x2*)vp, hi = *(const u32x2*)(vp + 16);
            oacc[db] = mfma16(mk8(lo[0], lo[1], hi[0], hi[1]), pf[kb], oacc[db]);
        }
}

constexpr int AT_Q = 0, AT_BUF = 34816, AT_BUFSZ = 17408 + 18432, AT_VOFF = 17408, AT_F = AT_BUF + 2 * AT_BUFSZ;
struct TileRegs { u32x4 k[2], v[2]; };
__device__ __forceinline__ void tile_load(TileRegs& t, const bf16_t* P, int r0, int rstride, int kcol, int vcol, int tid) {
#pragma unroll
    for (int i = 0; i < 2; ++i) {
        const int idx = tid + 512 * i;
        t.k[i] = *(const u32x4*)(P + pidx(r0 + (idx >> 4) * rstride, kcol + (idx & 15) * 8));
        t.v[i] = *(const u32x4*)(P + pidx(r0 + (idx & 63) * rstride, vcol + (idx >> 6) * 8));
    }
}
__device__ __forceinline__ void tile_write(const TileRegs& t, unsigned char* buf, const f32x4& g0, const f32x4& g1, int tid, int lane) {
    bf16_t* Ks = (bf16_t*)buf; bf16_t* VT = (bf16_t*)(buf + AT_VOFF);
#pragma unroll
    for (int i = 0; i < 2; ++i) {
        const int idx = tid + 512 * i, r = idx >> 4, ch = idx & 15;
        const u32x4 raw = t.k[i];
        float v[8] = {bflo(raw[0]), bfhi(raw[0]), bflo(raw[1]), bfhi(raw[1]), bflo(raw[2]), bfhi(raw[2]), bflo(raw[3]), bfhi(raw[3])};
        float ss = 0.f;
#pragma unroll
        for (int j = 0; j < 8; ++j) ss += v[j] * v[j];
        ss += shx(ss, 1, lane); ss += shx(ss, 2, lane); ss += shx(ss, 4, lane); ss += shx(ss, 8, lane);
        const float inv = rsqrtf(ss * (1.f / 128.f) + EPS);
        u32x4 o = {pk2(v[0] * inv * g0[0], v[1] * inv * g0[1]), pk2(v[2] * inv * g0[2], v[3] * inv * g0[3]),
                   pk2(v[4] * inv * g1[0], v[5] * inv * g1[1]), pk2(v[6] * inv * g1[2], v[7] * inv * g1[3])};
        *(u32x4*)(Ks + r * 136 + ch * 8) = o;
        const u32x4 rv = t.v[i];
        bf16_t* d = VT + ((idx >> 6) * 8) * 72 + (idx & 63);
        d[0] = (bf16_t)(rv[0] & 0xffff); d[72] = (bf16_t)(rv[0] >> 16); d[144] = (bf16_t)(rv[1] & 0xffff); d[216] = (bf16_t)(rv[1] >> 16);
        d[288] = (bf16_t)(rv[2] & 0xffff); d[360] = (bf16_t)(rv[2] >> 16); d[432] = (bf16_t)(rv[3] & 0xffff); d[504] = (bf16_t)(rv[3] >> 16);
    }
}

__device__ __forceinline__ void sb_item(const Params& p, int item, int l, unsigned char* lds) {
    const int tid = tidx(), w = tid >> 6, lane = tid & 63, fr = lane & 15, fq = lane >> 4;
    const bf16_t* P = (const bf16_t*)(p.ws + W_PROJ);
    bf16_t* OSB = (bf16_t*)(p.ws + W_OCAT);
    const int head = item >> 6, I = 63 - (item & 63);
    bf16_t* Qs = (bf16_t*)(lds + AT_Q); float* flags = (float*)(lds + AT_F);
    const float* gq = p.in[7] + l * 128; const float* gk = p.in[8] + l * 128;
    const f32x4 gk0 = *(const f32x4*)(gk + (tid & 15) * 8), gk1 = *(const f32x4*)(gk + (tid & 15) * 8 + 4);
    const int kcol = C_KSB + head * 128, vcol = C_VSB + head * 128;
    __syncthreads();
    TileRegs tr;
    int J = 2 * I + 1;
    tile_load(tr, P, 64 * J, 1, kcol, vcol, tid);
    stage_rows128_norm(Qs, P, 128 * I, 1, C_QSB + head * 128, gq, 0.08838834764831845f);
    tile_write(tr, lds + AT_BUF, gk0, gk1, tid, lane);
    tile_load(tr, P, 64 * (J - 1), 1, kcol, vcol, tid);
    __syncthreads();
    bf16x8 qf[4];
#pragma unroll
    for (int ks = 0; ks < 4; ++ks) qf[ks] = *(const bf16x8*)(Qs + (16 * w + fr) * 136 + 32 * ks + 8 * fq);
    f32x4 oacc[8];
#pragma unroll
    for (int db = 0; db < 8; ++db) oacc[db] = (f32x4){0.f, 0.f, 0.f, 0.f};
    float R = 1.f;
    const int tq = 128 * I + 16 * w + fr;
    constexpr float SB_EXIT = 1e-9f;
    int cur = 0;
    for (;;) {
        const bf16_t* Ks = (const bf16_t*)(lds + AT_BUF + cur * AT_BUFSZ); const bf16_t* VT = (const bf16_t*)(lds + AT_BUF + cur * AT_BUFSZ + AT_VOFF);
        const bool allmasked = 64 * J >= 128 * I + 16 * w + 15;
        if (!allmasked) {
            f32x4 s[4];
#pragma unroll
            for (int b = 0; b < 4; ++b) {
                s[b] = (f32x4){0.f, 0.f, 0.f, 0.f};
#pragma unroll
                for (int ks = 0; ks < 4; ++ks) s[b] = mfma16(*(const bf16x8*)(Ks + (16 * b + fr) * 136 + 32 * ks + 8 * fq), qf[ks], s[b]);
            }
            float beta[4][4], omb[4][4], lat[4], tot[4], wgt[4][4];
#pragma unroll
            for (int b = 0; b < 4; ++b) {
#pragma unroll
                for (int r = 0; r < 4; ++r) {
                    const int key = 64 * J + 16 * b + 4 * fq + r;
                    const float z = fminf(fmaxf(s[b][r], -80.f), 80.f);
                    const float e = __expf(-z), bt = __builtin_amdgcn_rcpf(1.f + e);
                    const bool valid = key < tq;
                    beta[b][r] = valid ? bt : 0.f; omb[b][r] = valid ? e * bt : 1.f;
                }
                const float g = omb[b][0] * omb[b][1] * omb[b][2] * omb[b][3];
                const float g1 = shx(g, 16, lane), g2 = shx(g, 32, lane), g3 = shx(g, 48, lane);
                lat[b] = fq == 0 ? g1 * g2 * g3 : (fq == 1 ? g2 * g3 : (fq == 2 ? g1 : 1.f));
                tot[b] = g * g1 * g2 * g3;
            }
            float cb = R;
#pragma unroll
            for (int b = 3; b >= 0; --b) {
                float c = cb * lat[b];
#pragma unroll
                for (int r = 3; r >= 0; --r) { wgt[b][r] = beta[b][r] * c; c *= omb[b][r]; }
                cb *= tot[b];
            }
            R = cb;
            pv_tile(oacc, VT, 72, 0, wgt, fr, fq);
        }
        float rm = R;
#pragma unroll
        for (int o = 32; o > 0; o >>= 1) rm = fmaxf(rm, shx(rm, o, lane));
        if (lane == 0) flags[cur * 8 + w] = rm;
        if (J == 0) break;
        tile_write(tr, lds + AT_BUF + (cur ^ 1) * AT_BUFSZ, gk0, gk1, tid, lane);
        if (J >= 2) tile_load(tr, P, 64 * (J - 2), 1, kcol, vcol, tid);
        __syncthreads();
        float mx = 0.f;
#pragma unroll
        for (int q = 0; q < 8; ++q) mx = fmaxf(mx, flags[cur * 8 + q]);
        if (mx < SB_EXIT) break;
        cur ^= 1; --J;
    }
    bf16_t* op = OSB + (size_t)tq * D + head * 128 + 4 * fq;
#pragma unroll
    for (int db = 0; db < 8; ++db) { u32x2 o = {pk2(oacc[db][0], oacc[db][1]), pk2(oacc[db][2], oacc[db][3])}; *(u32x2*)(op + 16 * db) = o; }
}

__device__ __forceinline__ void dil_item(const Params& p, int item, int l, unsigned char* lds) {
    const int tid = tidx(), w = tid >> 6, lane = tid & 63, fr = lane & 15, fq = lane >> 4;
    const bf16_t* P = (const bf16_t*)(p.ws + W_PROJ);
    float* ODG = (float*)(p.ws + W_ODG); float* LSE = (float*)(p.ws + W_LSE);
    const int g = item >> 7, rem = item & 127, hh = rem >> 6, s6 = rem & 63;
    const int r = g == 0 ? 1 : (g == 1 ? 4 : 16), nb = 64 / r, rho = s6 / nb, n = s6 % nb;
    const int head = 2 * g + hh;
    const float slope = exp2f(-8.f * (float)(head + 1) / 6.f) * (float)r;
    bf16_t* Qs = (bf16_t*)(lds + AT_Q);
    const float* gq = p.in[9] + l * 128; const float* gk = p.in[10] + l * 128;
    const f32x4 gk0 = *(const f32x4*)(gk + (tid & 15) * 8), gk1 = *(const f32x4*)(gk + (tid & 15) * 8 + 4);
    const int kcol = C_KDIL + head * 128, vcol = C_VDIL + head * 128;
    __syncthreads();
    TileRegs tr;
    int c = n == 0 ? 2 : 0;
    tile_load(tr, P, (128 * (n - 1) + 64 * c) * r + rho, r, kcol, vcol, tid);
    stage_rows128_norm(Qs, P, (128 * n) * r + rho, r, C_QDIL + head * 128, gq, 0.08838834764831845f);
    tile_write(tr, lds + AT_BUF, gk0, gk1, tid, lane);
    tile_load(tr, P, (128 * (n - 1) + 64 * (c + 1)) * r + rho, r, kcol, vcol, tid);
    __syncthreads();
    bf16x8 qf[4];
#pragma unroll
    for (int ks = 0; ks < 4; ++ks) qf[ks] = *(const bf16x8*)(Qs + (16 * w + fr) * 136 + 32 * ks + 8 * fq);
    f32x4 oacc[8];
#pragma unroll
    for (int db = 0; db < 8; ++db) oacc[db] = (f32x4){0.f, 0.f, 0.f, 0.f};
    float lsum = 0.f;
    const int iq = 16 * w + fr;
    int cur = 0;
    for (;;) {
        const bf16_t* Ks = (const bf16_t*)(lds + AT_BUF + cur * AT_BUFSZ); const bf16_t* VT = (const bf16_t*)(lds + AT_BUF + cur * AT_BUFSZ + AT_VOFF);
        const int dmax = 128 + 16 * w + 15 - 64 * c, dmin = 128 + 16 * w - 64 * c - 63;
        if (!(dmax < 0 || dmin > 128)) {
            float wgt[4][4];
#pragma unroll
            for (int b = 0; b < 4; ++b) {
                f32x4 sc = {0.f, 0.f, 0.f, 0.f};
#pragma unroll
                for (int ks = 0; ks < 4; ++ks) sc = mfma16(*(const bf16x8*)(Ks + (16 * b + fr) * 136 + 32 * ks + 8 * fq), qf[ks], sc);
#pragma unroll
                for (int q = 0; q < 4; ++q) {
                    const int delta = 128 + iq - 64 * c - (16 * b + 4 * fq + q);
                    const bool valid = delta >= 0 && delta <= 128;
                    const float pe = valid ? __expf(sc[q] - slope * (float)delta) : 0.f;
                    wgt[b][q] = pe; lsum += pe;
                }
            }
            pv_tile(oacc, VT, 72, 0, wgt, fr, fq);
        }
        if (c == 3) break;
        tile_write(tr, lds + AT_BUF + (cur ^ 1) * AT_BUFSZ, gk0, gk1, tid, lane);
        if (c + 2 <= 3) tile_load(tr, P, (128 * (n - 1) + 64 * (c + 2)) * r + rho, r, kcol, vcol, tid);
        __syncthreads();
        cur ^= 1; ++c;
    }
    lsum += shx(lsum, 16, lane); lsum += shx(lsum, 32, lane);
    const float inv = 1.f / lsum;
    const int t = (128 * n + iq) * r + rho;
    float* op = ODG + ((size_t)g * T + t) * 256 + hh * 128 + 4 * fq;
#pragma unroll
    for (int db = 0; db < 8; ++db) *(f32x4*)(op + 16 * db) = oacc[db] * inv;
    if (fq == 0) LSE[(size_t)(g * 2 + hh) * T + t] = __logf(lsum);
}

__device__ __forceinline__ void gla1_item(const Params& p, int item, int l, unsigned char* lds) {
    const int tid = tidx(), w = tid >> 6, lane = tid & 63, fr = lane & 15, fq = lane >> 4;
    const bf16_t* P = (const bf16_t*)(p.ws + W_PROJ);
    const float* agla = (const float*)(p.ws + W_AGLA);
    float* DL = (float*)(p.ws + W_DL); bf16_t* U = (bf16_t*)(p.ws + W_U); float* CUM = (float*)(p.ws + W_CUM);
    const float* wa = p.in[11] + (size_t)l * 16 * 512; const float* ba = p.in[12] + l * 512;
    const int h = item >> 7, n = item & 127, t0 = 64 * n;
    float* cum = (float*)lds; bf16_t* Kr = (bf16_t*)(lds + 32768); bf16_t* KT = (bf16_t*)(lds + 50176); bf16_t* VT = (bf16_t*)(lds + 68608); float* segt = (float*)(lds + 105472);
    __syncthreads();
    {
        const int d = tid & 127, c0 = tid >> 7;
        float wv[16];
#pragma unroll
        for (int q = 0; q < 16; ++q) wv[q] = wa[q * 512 + h * 128 + d];
        const float bias = ba[h * 128 + d];
#pragma unroll 4
        for (int i = 0; i < 16; ++i) {
            const int c = c0 + 4 * i;
            const float* ar = agla + (size_t)(t0 + c) * 16;
            float a = bias;
#pragma unroll
            for (int q4 = 0; q4 < 4; ++q4) { const f32x4 t4 = *(const f32x4*)(ar + q4 * 4); a += t4[0] * wv[q4 * 4] + t4[1] * wv[q4 * 4 + 1] + t4[2] * wv[q4 * 4 + 2] + t4[3] * wv[q4 * 4 + 3]; }
            const float ls = fminf(a, 0.f) - __logf(1.f + __expf(-fabsf(a)));
            cum[c * 128 + d] = ls * (1.f / 16.f);
        }
    }
    for (int idx = tid; idx < 1024; idx += 512) {
        const int r = idx >> 4, ch = idx & 15;
        *(u32x4*)(Kr + r * 136 + ch * 8) = *(const u32x4*)(P + pidx(t0 + r, C_KG + h * 128 + ch * 8));
    }
    stage_vt<64>(VT, 72, P, t0, 1, C_VG + h * 256, 32);
    __syncthreads();
    {
        const int d = tid & 127, sg = tid >> 7;
        float v[16]; float run = 0.f;
#pragma unroll
        for (int i = 0; i < 16; ++i) { run += cum[(16 * sg + i) * 128 + d]; v[i] = run; }
        segt[sg * 128 + d] = run;
        __syncthreads();
        float off = 0.f;
#pragma unroll
        for (int q = 0; q < 3; ++q) off += (q < sg) ? segt[q * 128 + d] : 0.f;
#pragma unroll
        for (int i = 0; i < 16; ++i) { const float c = v[i] + off; cum[(16 * sg + i) * 128 + d] = c; CUM[(size_t)(t0 + 16 * sg + i) * 512 + h * 128 + d] = c; }
        if (sg == 3) DL[(size_t)(h * 128 + n) * 128 + d] = __expf(v[15] + off);
    }
    __syncthreads();
    for (int idx = tid; idx < 1024; idx += 512) {
        const int key = idx & 63, ch = idx >> 6;
        const u32x4 raw = *(const u32x4*)(Kr + key * 136 + ch * 8);
        const float kv[8] = {bflo(raw[0]), bfhi(raw[0]), bflo(raw[1]), bfhi(raw[1]), bflo(raw[2]), bfhi(raw[2]), bflo(raw[3]), bfhi(raw[3])};
#pragma unroll
        for (int e = 0; e < 8; ++e) {
            const int d = ch * 8 + e;
            const float f = __expf(cum[63 * 128 + d] - cum[key * 128 + d]);
            KT[d * 72 + key] = (bf16_t)(pk2(kv[e] * f, 0.f) & 0xffff);
        }
    }
    __syncthreads();
    bf16x8 kf[2];
#pragma unroll
    for (int ks = 0; ks < 2; ++ks) kf[ks] = *(const bf16x8*)(KT + (16 * w + fr) * 72 + 32 * ks + 8 * fq);
    bf16_t* up = U + ((size_t)(h * 128 + n) * 256 + fr) * 128 + 16 * w + 4 * fq;
#pragma unroll
    for (int eb = 0; eb < 16; ++eb) {
        f32x4 a = {0.f, 0.f, 0.f, 0.f};
#pragma unroll
        for (int ks = 0; ks < 2; ++ks) a = mfma16(kf[ks], *(const bf16x8*)(VT + (16 * eb + fr) * 72 + 32 * ks + 8 * fq), a);
        u32x2 o = {pk2(a[0], a[1]), pk2(a[2], a[3])};
        *(u32x2*)(up + (size_t)(16 * eb) * 128) = o;
    }
}

__device__ __forceinline__ void gla2_phase(const Params& p) {
    const float* DL = (const float*)(p.ws + W_DL); const bf16_t* U = (const bf16_t*)(p.ws + W_U); bf16_t* SP = (bf16_t*)(p.ws + W_SP);
    const int total = gridDim.x * 512;
    for (int idx = bidx() * 512 + tidx(); idx < 4 * 32768; idx += total) {
        const int h = idx >> 15, ed = idx & 32767, d = ed & 127;
        const bf16_t* up = U + (size_t)h * 128 * 32768 + ed; bf16_t* sp = SP + (size_t)h * 128 * 32768 + ed; const float* dp = DL + (size_t)h * 128 * 128 + d;
        float S = 0.f;
        for (int n0 = 0; n0 < 128; n0 += 16) {
            float tv[16], dv[16];
#pragma unroll
            for (int q = 0; q < 16; ++q) { tv[q] = bf1(up[(size_t)(n0 + q) * 32768]); dv[q] = dp[(n0 + q) * 128]; }
#pragma unroll
            for (int q = 0; q < 16; ++q) { sp[(size_t)(n0 + q) * 32768] = (bf16_t)(pk2(S, 0.f) & 0xffff); S = dv[q] * S + tv[q]; }
        }
    }
}

__device__ __forceinline__ void gla3_item(const Params& p, int item, int l, unsigned char* lds) {
    const int tid = tidx(), w = tid >> 6, lane = tid & 63, fr = lane & 15, fq = lane >> 4;
    const bf16_t* P = (const bf16_t*)(p.ws + W_PROJ);
    const float* cumg = (const float*)(p.ws + W_CUM);
    bf16_t* OG = (bf16_t*)(p.ws + W_OCAT) + 1024;
    const float* ogain = p.in[13] + l * 256;
    const int h = item >> 7, n = item & 127, t0 = 64 * n;
    float* cum = (float*)lds; bf16_t* ST = (bf16_t*)lds;
    bf16_t* Qp = (bf16_t*)(lds + 69632); bf16_t* Kp = (bf16_t*)(lds + 87040); bf16_t* VT = (bf16_t*)(lds + 104448);
    float* c31 = (float*)(lds + 141312); float* ssq = (float*)(lds + 141824);
    __syncthreads();
#pragma unroll
    for (int i = 0; i < 4; ++i) { const int idx = tid + 512 * i, c = idx >> 5, d4 = idx & 31; *(f32x4*)(cum + c * 128 + d4 * 4) = *(const f32x4*)(cumg + (size_t)(t0 + c) * 512 + h * 128 + d4 * 4); }
    u32x4 rq[2], rk[2];
#pragma unroll
    for (int i = 0; i < 2; ++i) {
        const int idx = tid + 512 * i, c = idx >> 4, ch = idx & 15;
        rq[i] = *(const u32x4*)(P + pidx(t0 + c, C_QG + h * 128 + ch * 8));
        rk[i] = *(const u32x4*)(P + pidx(t0 + c, C_KG + h * 128 + ch * 8));
    }
    stage_vt<64>(VT, 72, P, t0, 1, C_VG + h * 256, 32);
    __syncthreads();
    const bf16_t* sp = (const bf16_t*)(p.ws + W_SP) + (size_t)(h * 128 + n) * 32768;
    u32x4 sv[8];
#pragma unroll
    for (int i = 0; i < 8; ++i) { const int idx = tid + 512 * i, e = idx >> 4, ch = idx & 15; sv[i] = *(const u32x4*)(sp + e * 128 + ch * 8); }
    float f31[8];
    {
        const int ch = tid & 15;
#pragma unroll
        for (int j = 0; j < 8; ++j) f31[j] = __expf(cum[31 * 128 + ch * 8 + j]);
    }
#pragma unroll
    for (int i = 0; i < 2; ++i) {
        const int idx = tid + 512 * i, c = idx >> 4, ch = idx & 15;
        const float qv[8] = {bflo(rq[i][0]), bfhi(rq[i][0]), bflo(rq[i][1]), bfhi(rq[i][1]), bflo(rq[i][2]), bfhi(rq[i][2]), bflo(rq[i][3]), bfhi(rq[i][3])};
        const float kv[8] = {bflo(rk[i][0]), bfhi(rk[i][0]), bflo(rk[i][1]), bfhi(rk[i][1]), bflo(rk[i][2]), bfhi(rk[i][2]), bflo(rk[i][3]), bfhi(rk[i][3])};
        float qo[8], ko[8];
#pragma unroll
        for (int e = 0; e < 8; ++e) {
            const int d = ch * 8 + e;
            const float df = cum[c * 128 + d] - cum[31 * 128 + d];
            qo[e] = qv[e] * 0.08838834764831845f * __expf(df); ko[e] = kv[e] * __expf(-df);
        }
        u32x4 oq = {pk2(qo[0], qo[1]), pk2(qo[2], qo[3]), pk2(qo[4], qo[5]), pk2(qo[6], qo[7])};
        u32x4 ok = {pk2(ko[0], ko[1]), pk2(ko[2], ko[3]), pk2(ko[4], ko[5]), pk2(ko[6], ko[7])};
        *(u32x4*)(Qp + c * 136 + ch * 8) = oq; *(u32x4*)(Kp + c * 136 + ch * 8) = ok;
    }
    __syncthreads();
#pragma unroll
    for (int i = 0; i < 8; ++i) {
        const int idx = tid + 512 * i, e = idx >> 4, ch = idx & 15;
        u32x4 o = {pk2(bflo(sv[i][0]) * f31[0], bfhi(sv[i][0]) * f31[1]), pk2(bflo(sv[i][1]) * f31[2], bfhi(sv[i][1]) * f31[3]),
                   pk2(bflo(sv[i][2]) * f31[4], bfhi(sv[i][2]) * f31[5]), pk2(bflo(sv[i][3]) * f31[6], bfhi(sv[i][3]) * f31[7])};
        *(u32x4*)(ST + e * 136 + ch * 8) = o;
    }
    __syncthreads();
    const int ib = w & 3, eh = w >> 2, iq = 16 * ib + fr;
    bf16x8 qf[4];
#pragma unroll
    for (int ks = 0; ks < 4; ++ks) qf[ks] = *(const bf16x8*)(Qp + iq * 136 + 32 * ks + 8 * fq);
    float wgt[4][4];
#pragma unroll
    for (int jb = 0; jb < 4; ++jb) {
        f32x4 s = {0.f, 0.f, 0.f, 0.f};
        if (jb <= ib) {
#pragma unroll
            for (int ks = 0; ks < 4; ++ks) s = mfma16(*(const bf16x8*)(Kp + (16 * jb + fr) * 136 + 32 * ks + 8 * fq), qf[ks], s);
        }
#pragma unroll
        for (int q = 0; q < 4; ++q) wgt[jb][q] = (16 * jb + 4 * fq + q <= iq) ? s[q] : 0.f;
    }
    bf16x8 pf[2];
#pragma unroll
    for (int kb = 0; kb < 2; ++kb) pf[kb] = mk8(pk2(wgt[2 * kb][0], wgt[2 * kb][1]), pk2(wgt[2 * kb][2], wgt[2 * kb][3]), pk2(wgt[2 * kb + 1][0], wgt[2 * kb + 1][1]), pk2(wgt[2 * kb + 1][2], wgt[2 * kb + 1][3]));
    f32x4 o[8]; float sq = 0.f;
#pragma unroll
    for (int ebl = 0; ebl < 8; ++ebl) {
        const int eb = 8 * eh + ebl;
        f32x4 a = {0.f, 0.f, 0.f, 0.f};
#pragma unroll
        for (int ks = 0; ks < 4; ++ks) a = mfma16(*(const bf16x8*)(ST + (16 * eb + fr) * 136 + 32 * ks + 8 * fq), qf[ks], a);
#pragma unroll
        for (int kb = 0; kb < 2; ++kb) {
            const bf16_t* vp = VT + (16 * eb + fr) * 72 + 32 * kb + 4 * fq;
            const u32x2 lo = *(const u32x2*)vp, hi = *(const u32x2*)(vp + 16);
            a = mfma16(mk8(lo[0], lo[1], hi[0], hi[1]), pf[kb], a);
        }
        o[ebl] = a; sq += a[0] * a[0] + a[1] * a[1] + a[2] * a[2] + a[3] * a[3];
    }
    sq += shx(sq, 16, lane); sq += shx(sq, 32, lane);
    if (fq == 0) ssq[eh * 64 + iq] = sq;
    __syncthreads();
    const float rinv = rsqrtf((ssq[iq] + ssq[64 + iq]) * (1.f / 256.f) + EPS);
    const size_t trow = (size_t)(t0 + iq);
#pragma unroll
    for (int ebl = 0; ebl < 8; ++ebl) {
        const int e = 16 * (8 * eh + ebl) + 4 * fq;
        const u32x2 rr = *(const u32x2*)(P + pidx((int)trow, C_RG + h * 256 + e));
        const f32x4 gn = *(const f32x4*)(ogain + e);
        const float y0 = o[ebl][0] * rinv * gn[0] * siluf_(bflo(rr[0])), y1 = o[ebl][1] * rinv * gn[1] * siluf_(bfhi(rr[0]));
        const float y2 = o[ebl][2] * rinv * gn[2] * siluf_(bflo(rr[1])), y3 = o[ebl][3] * rinv * gn[3] * siluf_(bfhi(rr[1]));
        u32x2 ov = {pk2(y0, y1), pk2(y2, y3)};
        *(u32x2*)(OG + trow * D + h * 256 + e) = ov;
    }
}

__device__ __forceinline__ void dilmix_phase(const Params& p) {
    const float* ODG = (const float*)(p.ws + W_ODG); const float* LSE = (const float*)(p.ws + W_LSE);
    bf16_t* OD = (bf16_t*)(p.ws + W_OCAT) + 768;
    const int total = gridDim.x * 512;
    for (int idx = bidx() * 512 + tidx(); idx < T * 64; idx += total) {
        const int t = idx >> 6, c4 = idx & 63, hh = c4 >> 5;
        const float l0 = LSE[(size_t)(0 + hh) * T + t], l1 = LSE[(size_t)(2 + hh) * T + t], l2 = LSE[(size_t)(4 + hh) * T + t];
        const float m = fmaxf(l0, fmaxf(l1, l2));
        const float e0 = __expf(l0 - m), e1 = __expf(l1 - m), e2 = __expf(l2 - m), inv = 1.f / (e0 + e1 + e2);
        const f32x4 a0 = *(const f32x4*)(ODG + ((size_t)0 * T + t) * 256 + c4 * 4), a1 = *(const f32x4*)(ODG + ((size_t)1 * T + t) * 256 + c4 * 4), a2 = *(const f32x4*)(ODG + ((size_t)2 * T + t) * 256 + c4 * 4);
        const f32x4 y = (a0 * e0 + a1 * e1 + a2 * e2) * inv;
        u32x2 o = {pk2(y[0], y[1]), pk2(y[2], y[3])};
        *(u32x2*)(OD + (size_t)t * D + c4 * 4) = o;
    }
}

#define XB_TMO      128
#define XB_XCNT(j)  (256  + 64 * (j))
#define XB_XSUB(j)  (1280 + 64 * (j))
#define XB_XGEN(j)  (2304 + 64 * (j))
#define XB_TOP      3328
#define XB_TOPGEN   3392
#define XCD_BAR_WORDS 3456
#define XB_SPIN_CAP (1u << 18)
__device__ __forceinline__ unsigned xb_xcc_id() { return (unsigned)__builtin_amdgcn_s_getreg((3 << 11) | 20) & 0xFu; }
#define XB_SPIN(cond, bar) do { unsigned _sp = 0; while (cond) { __builtin_amdgcn_s_sleep(1); \
    if ((++_sp & 255u) == 0u) { if (xb_ld(&(bar)[XB_TMO])) break; if (_sp > XB_SPIN_CAP) { atomicAdd(&(bar)[XB_TMO], 1u); break; } } } } while (0)
struct XcdBarrier { unsigned* bar; unsigned x; volatile LAS unsigned* st; };
__device__ __forceinline__ XcdBarrier xcd_barrier_post(unsigned* bar, volatile LAS unsigned* st) {
    XcdBarrier b; b.bar = bar; b.x = xb_xcc_id(); b.st = st;
    if (threadIdx.x == 0) st[3] = xb_add(&bar[XB_XCNT(b.x)], 1u);
    return b;
}
__device__ __forceinline__ void xcd_barrier_complete(unsigned* bar, unsigned x, unsigned& nloc, unsigned& nx) {
    const unsigned G = gridDim.x * gridDim.y * gridDim.z;
    unsigned sum, cnt, mine, sp = 0u;
    for (;;) {
        sum = 0u; cnt = 0u; mine = 0u;
#pragma unroll
        for (unsigned j = 0; j < 16; ++j) { const unsigned c = xb_ld(&bar[XB_XCNT(j)]); sum += c; cnt += (c > 0u) ? 1u : 0u; mine = (j == x) ? c : mine; }
        if (sum == G) break;
        __builtin_amdgcn_s_sleep(1);
        if ((++sp & 255u) == 0u) { if (xb_ld(&bar[XB_TMO])) break; if (sp > XB_SPIN_CAP) { atomicAdd(&bar[XB_TMO], 1u); break; } }
    }
    nloc = mine > 0u ? mine : 1u; nx = cnt > 0u ? cnt : 1u;
}
__device__ __forceinline__ void xcd_barrier(const XcdBarrier& b) {
    asm volatile("s_waitcnt vmcnt(0)" ::: "memory");
    __syncthreads();
    if (threadIdx.x == 0) {
        unsigned* bar = b.bar; asm volatile("" : "+s"(bar));
        __builtin_amdgcn_s_waitcnt(0);
        unsigned nloc = b.st[0], nx = b.st[1];
        if (nloc == 0u) { xcd_barrier_complete(bar, b.x, nloc, nx); b.st[0] = nloc; b.st[1] = nx; }
        const unsigned old = xb_add(&bar[XB_XSUB(b.x)], 1u);
        const unsigned gen = old / nloc;
        if (old + 1u == (gen + 1u) * nloc) {
            __builtin_amdgcn_fence(__ATOMIC_RELEASE, "agent");
            asm volatile("s_waitcnt vmcnt(0)" ::: "memory");
            const unsigned og = xb_add(&bar[XB_TOP], 1u);
            const unsigned tg = og / nx;
            if (og + 1u == (tg + 1u) * nx) xb_add(&bar[XB_TOPGEN], 1u);
            else XB_SPIN(xb_ld(&bar[XB_TOPGEN]) == tg, bar);
            __builtin_amdgcn_fence(__ATOMIC_ACQUIRE, "agent");
            asm volatile("s_waitcnt vmcnt(0)" ::: "memory");
        } else {
            XB_SPIN(xb_ld(&bar[XB_TOPGEN]) == gen, bar);
            __builtin_amdgcn_fence(__ATOMIC_ACQUIRE, "agent");
            asm volatile("s_waitcnt vmcnt(0)" ::: "memory");
        }
    }
    __syncthreads();
}

constexpr int PH_PER_LAYER = 10, N_PHASES = 1 + 2 * PH_PER_LAYER;

__device__ __forceinline__ void gemm_job(const Params& p, int l, int gi, unsigned char* lds) {
    unsigned char* wl = p.ws + (size_t)l * SZ_WL;
    pg8::Gemm g; EpiAny E{0, false, l, p, false};
    const bool canfuse = gridDim.x == 256;
    g.M = T; g.N = D; g.K = D; g.A = (const bf16_t*)(p.ws + W_H); g.Bt = (const bf16_t*)wl;
    if (gi == 0) { g.N = NINP; g.Bt = (const bf16_t*)(wl + O_WIN); E.mode = 0; E.PERM = true; }
    else if (gi == 1) { g.A = (const bf16_t*)(p.ws + W_OCAT); g.Bt = (const bf16_t*)(wl + O_WBR); E.mode = 1; E.PERM = true; }
    else if (gi == 2) { g.A = (const bf16_t*)(p.ws + W_YB); g.Bt = (const bf16_t*)(wl + O_WOUT); E.mode = 4; E.PERM = true; E.fuse = canfuse; }
    else if (gi == 3) { g.N = 2 * DFF; g.Bt = (const bf16_t*)(wl + O_WFI); E.mode = 5; E.PERM = true; }
    else { g.K = DFF; g.A = (const bf16_t*)(p.ws + W_PROJ); g.Bt = (const bf16_t*)(wl + O_WFO); E.mode = 6; E.PERM = true; E.fuse = canfuse && l == 0; }
    pg8::StaticOrder S; S.init(g.M, g.N, gridDim.x, (int)*(volatile LAS unsigned*)(LAS unsigned char*)(lds + LDS_BYTES - 8));
    pg8::gemm_phase((LAS unsigned char*)lds, g, S, E);
    const int c = S.c;
    if (gridDim.x == 256) {
        if (gi == 0 && c >= 224) { if (l == 0) conv_phase(p, lds, CV_PER_LAYER, CV_DEF_A, 0, 0, c - 224, 32); else conv_phase(p, lds, CV_PER_LAYER + CV_DEF_C, CV_DEF_D - CV_DEF_C, 0, 0, c - 224, 32); }
        if (gi == 3 && c >= 128) { if (l == 0) conv_phase(p, lds, CV_PER_LAYER + CV_DEF_A, CV_DEF_B - CV_DEF_A, 0, 0, c - 128, 128); else conv_phase(p, lds, CV_PER_LAYER + CV_DEF_D, CV_PER_LAYER - CV_DEF_D, 0, 0, c - 128, 128); }
    } else if (bidx() == 0 && (gi == 0 || gi == 3)) {
        if (gi == 0) { if (l == 0) conv_phase(p, lds, CV_PER_LAYER, CV_DEF_A, 0, 0, 0, 1); else conv_phase(p, lds, CV_PER_LAYER + CV_DEF_C, CV_DEF_D - CV_DEF_C, 0, 0, 0, 1); }
        else { if (l == 0) conv_phase(p, lds, CV_PER_LAYER + CV_DEF_A, CV_DEF_B - CV_DEF_A, 0, 0, 0, 1); else conv_phase(p, lds, CV_PER_LAYER + CV_DEF_D, CV_PER_LAYER - CV_DEF_D, 0, 0, 0, 1); }
    }
}

__device__ __forceinline__ void run_phase(const Params& p0, int ph, unsigned char* lds) {
    Params p = p0; asm volatile("" : "+s"(p.ws));
    const int G = gridDim.x, bid = bidx();
    if (ph == 0) {
        for (int it = bid; it < 256; it += G) mod_item(p, it, lds);
        conv_phase(p, lds, 0, CV_PER_LAYER, CV_PER_LAYER + CV_DEF_B, CV_DEF_C - CV_DEF_B, bid, G);
        return;
    }
    const int l = (ph - 1) / PH_PER_LAYER, q = (ph - 1) % PH_PER_LAYER;
    const float* MOD = (const float*)(p.ws + W_MOD) + l * 12288;
    float* X = (float*)(p.ws + W_X);
    const float* xin = l == 0 ? p.in[0] : X;
    bf16_t* H = (bf16_t*)(p.ws + W_H);
    int g0 = 0, g1 = -1;
    switch (q) {
    case 0: norm_phase(xin, p.in[4] + l * D, MOD, MOD + 2048, H); break;
    case 1: g0 = 0; g1 = 0; break;
    case 2:
        for (int it = bid; it < 1280; it += G) { if (it < 384) sb_item(p, it, l, lds); else if (it < 768) dil_item(p, it - 384, l, lds); else gla1_item(p, it - 768, l, lds); }
        break;
    case 3: gla2_phase(p); break;
    case 4:
        for (int it = bid; it < 512; it += G) gla3_item(p, it, l, lds);
        dilmix_phase(p);
        break;
    case 5: g0 = 1; g1 = 1; break;
    case 6: g0 = 2; g1 = 2; break;
    case 7: norm_phase(X, p.in[5] + l * D, MOD + 6144, MOD + 8192, H); break;
    case 8: g0 = 3; g1 = 3; break;
    case 9: g0 = 4; g1 = 4; break;
    }
#pragma unroll 1
    for (int gi = g0; gi <= g1; ++gi) { __syncthreads(); gemm_job(p, l, gi, lds); }
}

__global__ void __launch_bounds__(512, 2) fwd_megakernel(Params p) {
    extern __shared__ __attribute__((aligned(16))) unsigned char lds[];
    cg::grid_group grid = cg::this_grid();
    volatile LAS unsigned* st = (volatile LAS unsigned*)(LAS unsigned char*)(lds + LDS_BYTES - 16);
    if (threadIdx.x == 0) { st[0] = 0u; st[1] = 0u; st[2] = blockIdx.x; }
    __syncthreads();
    const XcdBarrier xb = xcd_barrier_post((unsigned*)(p.ws + W_BAR), st);
    if (p.ph_lo < 0) grid.sync();
#define GSYNC(ph) xcd_barrier(xb)
    for (int ph = p.ph_lo; ph < p.ph_hi; ++ph) {
        if (gridDim.x == 256 && ph >= 1) {
            const int l = (ph - 1) / PH_PER_LAYER, q = (ph - 1) % PH_PER_LAYER;
            if (q == 7 || (q == 0 && l == 1)) continue;
        }
        run_phase(p, ph, lds);
        if (ph + 1 < p.ph_hi) GSYNC(ph);
        if (ph == 0) {
            if (threadIdx.x == 0) {
                unsigned* bar = (unsigned*)(p.ws + W_BAR); bool ok = (gridDim.x & 7u) == 0u;
                for (unsigned j = 0; j < 16; ++j) { const unsigned c = xb_ld(&bar[XB_XCNT(j)]); ok = ok && (c == (j < 8 ? gridDim.x / 8u : 0u)); }
                if (ok) st[2] = st[3] * 8u + xb.x;
            }
            __syncthreads();
        }
    }
}

extern "C" void kernel_launch(void* const* d_in, const int* in_sizes, int n_in, void* d_out, int out_size, void* d_ws, size_t ws_size, hipStream_t stream) {
    static int grid_blocks = 0;
    if (!grid_blocks) {
        int dev = 0, cus = 0, per_cu = 0;
        hipGetDevice(&dev);
        hipDeviceGetAttribute(&cus, hipDeviceAttributeMultiprocessorCount, dev);
        hipFuncSetAttribute((const void*)fwd_megakernel, hipFuncAttributeMaxDynamicSharedMemorySize, LDS_BYTES);
        hipOccupancyMaxActiveBlocksPerMultiprocessor(&per_cu, (const void*)fwd_megakernel, 512, LDS_BYTES);
        if (per_cu < 1) { fprintf(stderr, "kernel_launch: occupancy query says %d blocks per CU\n", per_cu); per_cu = 1; }
        (void)hipGetLastError();
        grid_blocks = cus * per_cu;
        if (ws_size < W_END) { fprintf(stderr, "kernel_launch: workspace too small: %zu < %zu; nothing launched\n", ws_size, (size_t)W_END); grid_blocks = -1; }
    }
    if (grid_blocks < 0) return;
    Params p{};
    for (int i = 0; i < 20; ++i) p.in[i] = (const float*)d_in[i];
    p.out = (float*)d_out; p.ws = (unsigned char*)d_ws; p.ph_lo = 0; p.ph_hi = N_PHASES;
    (void)hipMemsetAsync((unsigned char*)d_ws + W_BAR, 0, 16384 + 3 * 32 * 256, stream);
    void* args[] = {&p};
    hipError_t e = hipLaunchCooperativeKernel((const void*)fwd_megakernel, dim3(grid_blocks), dim3(512), args, LDS_BYTES, stream);
    if (e != hipSuccess) fprintf(stderr, "cooperative launch failed: %s (grid %d)\n", hipGetErrorString(e), grid_blocks);
}
```

```cpp
#include <hip/hip_runtime.h>
#include <hip/hip_cooperative_groups.h>
#include <cstdio>
namespace cg = cooperative_groups;

#define LAS __attribute__((address_space(3)))
typedef unsigned short bf16_t;
typedef short bf16x8 __attribute__((ext_vector_type(8)));
typedef float f32x4 __attribute__((ext_vector_type(4)));
typedef unsigned u32x4 __attribute__((ext_vector_type(4)));
typedef unsigned u32x2 __attribute__((ext_vector_type(2)));

constexpr int T = 8192, D = 2048, NIN = 13840, NINP = 14080, DFF = 5632;
constexpr int C_QSB = 0, C_KSB = 768, C_VSB = 1536, C_QDIL = 2304, C_KDIL = 3072, C_VDIL = 3840, C_QG = 4608, C_KG = 5120, C_VG = 5632, C_RG = 6656, C_GATE = 7696;
constexpr float EPS = 1e-6f;
constexpr int LDS_BYTES = 143360;

constexpr size_t SZ_WIN = (size_t)NINP * D * 2, SZ_WBS = (size_t)D * 768 * 2, SZ_WBD = (size_t)D * 256 * 2, SZ_WBG = (size_t)D * 1024 * 2,
                 SZ_WOUT = (size_t)D * D * 2, SZ_WFI = (size_t)2 * DFF * D * 2, SZ_WFO = (size_t)D * DFF * 2;
constexpr size_t O_WIN = 0, O_WBR = O_WIN + SZ_WIN  , O_WOUT = O_WBR + SZ_WBS + SZ_WBD + SZ_WBG, O_WFI = O_WOUT + SZ_WOUT,
                 O_WFO = O_WFI + SZ_WFI, SZ_WL = O_WFO + SZ_WFO;
constexpr size_t W_MOD = 2 * SZ_WL;
constexpr size_t W_X = W_MOD + 2 * 12288 * 4;
constexpr size_t W_H = W_X + (size_t)T * D * 4;
constexpr size_t W_PROJ = W_H + (size_t)T * D * 2;
constexpr size_t W_AGLA = W_PROJ + (size_t)T * NINP * 2;
constexpr size_t W_ODG = W_AGLA + (size_t)T * 16 * 4;
constexpr size_t W_LSE = W_ODG + (size_t)3 * T * 256 * 4;
constexpr size_t W_DL = W_LSE + (size_t)3 * 2 * T * 4;
constexpr size_t W_U = W_DL + (size_t)4 * 128 * 128 * 4;
constexpr size_t W_SP = W_U + (size_t)4 * 128 * 32768 * 2;
constexpr size_t W_CUM = W_SP + (size_t)4 * 128 * 32768 * 2;
constexpr size_t W_OCAT = W_CUM + (size_t)T * 512 * 4;
constexpr size_t W_YB = W_OCAT + (size_t)T * D * 2;
constexpr size_t W_BAR = W_YB + (size_t)T * D * 2;
constexpr size_t W_FCNT = W_BAR + 16384;
constexpr size_t W_FSLOT = W_BAR + 65536;
constexpr size_t W_END = W_FSLOT + (size_t)3 * 32 * 256 * 8 * 4;

struct Params {
    const float* in[20];
    float* out;
    unsigned char* ws;
    int ph_lo, ph_hi;
};

typedef __bf16 bf16v2_t __attribute__((ext_vector_type(2)));
typedef float f32v2_t __attribute__((ext_vector_type(2)));
__device__ __forceinline__ unsigned pk2(float lo, float hi) { const f32v2_t v = {lo, hi}; return __builtin_bit_cast(unsigned, __builtin_convertvector(v, bf16v2_t)); }
__device__ __forceinline__ int tidx() { int t = threadIdx.x; asm volatile("" : "+v"(t)); return t; }
__device__ __forceinline__ int bidx() { int b = blockIdx.x; asm volatile("" : "+s"(b)); return b; }
__device__ __forceinline__ float shx(float v, int mask, int lane) { return __int_as_float(__builtin_amdgcn_ds_bpermute((lane ^ mask) << 2, __float_as_int(v))); }
__device__ __forceinline__ unsigned xb_ld(unsigned* p)              { return __hip_atomic_load(p, __ATOMIC_RELAXED, __HIP_MEMORY_SCOPE_AGENT); }
__device__ __forceinline__ unsigned xb_add(unsigned* p, unsigned v) { return __hip_atomic_fetch_add(p, v, __ATOMIC_RELAXED, __HIP_MEMORY_SCOPE_AGENT); }
__device__ __forceinline__ size_t pidx(int row, int col) { return (size_t)(col >> 7) * ((size_t)T * 128) + (size_t)row * 128 + (col & 127); }
__device__ __forceinline__ float bflo(unsigned u) { return __uint_as_float(u << 16); }
__device__ __forceinline__ float bfhi(unsigned u) { return __uint_as_float(u & 0xffff0000u); }
__device__ __forceinline__ float bf1(bf16_t b) { return __uint_as_float(((unsigned)b) << 16); }
__device__ __forceinline__ float sigmoidf_(float x) { return 1.f / (1.f + __expf(-x)); }
__device__ __forceinline__ float sigc(float x) { return __builtin_amdgcn_rcpf(1.f + __expf(-fminf(fmaxf(x, -30.f), 30.f))); }
__device__ __forceinline__ float sigratio(float a, float b) { return (1.f + __expf(-fminf(fmaxf(b, -30.f), 30.f))) * __builtin_amdgcn_rcpf(1.f + __expf(-fminf(fmaxf(a, -30.f), 30.f))); }
__device__ __forceinline__ float siluf_(float x) { return x * __builtin_amdgcn_rcpf(1.f + __expf(-fmaxf(x, -80.f))); }
__device__ __forceinline__ f32x4 mfma16(bf16x8 a, bf16x8 b, f32x4 c) { return __builtin_amdgcn_mfma_f32_16x16x32_bf16(a, b, c, 0, 0, 0); }
__device__ __forceinline__ bf16x8 mk8(unsigned a, unsigned b, unsigned c, unsigned d) { u32x4 v = {a, b, c, d}; return __builtin_bit_cast(bf16x8, v); }

namespace pg8 {
constexpr int BM = 256, BK = 64, HALF = 128, HTB = HALF * BK * 2, STAGE_BYTES = 8 * HTB, NXCD = 8, WGM = 8;
__host__ __device__ __forceinline__ int lds_byte(int r, int c) { const int st = (r >> 4) * 2 + (c >> 5), rr = r & 15, cc = c & 31, ob = rr * 64 + cc * 2; return st * 1024 + (ob ^ (((ob >> 9) & 1) << 5)); }
__host__ __device__ __forceinline__ void stage_rc(int b, int& R, int& C) { const int st = b / 1024, sb = b % 1024, swz = sb ^ (((sb >> 9) & 1) << 5); R = (st >> 1) * 16 + swz / 64; C = (st & 1) * 32 + (swz % 64) / 2; }
__host__ __device__ __forceinline__ int perm32(int rho) { const int n = rho >> 4, i = rho & 15; return 8 * (i >> 2) + 4 * n + (i & 3); }
struct Unit { int pm, pn; };
struct Gemm { const bf16_t* A; const bf16_t* Bt; int M, N, K; };
struct StaticOrder {
    int nM, nN, nwg, G, c;
    __host__ __device__ void init(int M, int N, int G_, int c_) { nM = M / BM; nN = N / BM; nwg = nM * nN; G = G_; c = c_; }
    __host__ __device__ bool next(int i, Unit& u) const {
        const long L = (long)i * G + c; if (L >= nwg) return false;
        int wgid = (int)L; { const int q = nwg / NXCD, r = nwg % NXCD, xcd = wgid % NXCD, off = wgid / NXCD; wgid = (xcd < r ? xcd * (q + 1) : r * (q + 1) + (xcd - r) * q) + off; }
        const int nig = WGM * nN, gid = wgid / nig, fm = gid * WGM, gsz = (nM - fm) < WGM ? (nM - fm) : WGM;
        u.pm = fm + ((wgid % nig) % gsz); u.pn = (wgid % nig) / gsz; return true;
    }
};

template <class Epi>
__device__ __forceinline__ void gemm_phase(LAS unsigned char* lds, const Gemm g, const StaticOrder& S, const Epi& E) {
    const int tid = tidx(), wid = __builtin_amdgcn_readfirstlane(tid >> 6), lane = tid & 63, wr = wid >> 2, wc = wid & 3, fr = lane & 15, fq = lane >> 4;
    const int K = g.K, nt = K / BK;
    unsigned voffA[2], voffB[2];
#pragma unroll
    for (int i = 0; i < 2; ++i) { int R, C; stage_rc(tid * 16 + i * 8192, R, C); const int Rb = E.PERM ? ((R & ~31) + perm32(R & 31)) : R;
        voffA[i] = (unsigned)(R * K + C) * 2u; voffB[i] = (unsigned)(Rb * K + C) * 2u; }
    const size_t kstep = (size_t)(BK * 2);
    const size_t hstep = (size_t)HALF * K * 2;
    const size_t tstep = 2 * hstep;
    const unsigned ldsw = (unsigned)wid * 1024u;
    const int aoff = lds_byte(wr * 64 + fr, fq * 8), boff = lds_byte(wc * 32 + fr, fq * 8);
#define PG8_SA(b, h) (((b) * 2 + (h)) * HTB)
#define PG8_SB(b, h) ((4 + (b) * 2 + (h)) * HTB)
#define PG8_STAGE(bufoff, gbase, voff) do { _Pragma("unroll") for (int _i = 0; _i < 2; ++_i) \
        __builtin_amdgcn_global_load_lds((const unsigned*)((const char*)(gbase) + (voff)[_i]), (LAS unsigned*)(lds + (bufoff) + ldsw + _i * 8192), 16, 0, 0); } while (0)
#define PG8_LDA(dst, b, h) do { _Pragma("unroll") for (int m = 0; m < 4; ++m) _Pragma("unroll") for (int k = 0; k < 2; ++k) dst[m][k] = *(const LAS bf16x8*)(lds + PG8_SA(b, h) + aoff + m * 2048 + k * 1024); } while (0)
#define PG8_LDB(dst, b, h) do { _Pragma("unroll") for (int n = 0; n < 2; ++n) _Pragma("unroll") for (int k = 0; k < 2; ++k) dst[n][k] = *(const LAS bf16x8*)(lds + PG8_SB(b, h) + boff + n * 2048 + k * 1024); } while (0)
#define PG8_MMA(ai, bj, At, Bt) do { __builtin_amdgcn_s_setprio(1); _Pragma("unroll") for (int m = 0; m < 4; ++m) _Pragma("unroll") for (int n = 0; n < 2; ++n) _Pragma("unroll") for (int k = 0; k < 2; ++k) \
        acc[ai][bj][m][n] = __builtin_amdgcn_mfma_f32_16x16x32_bf16(Bt[n][k], At[m][k], acc[ai][bj][m][n], 0, 0, 0); __builtin_amdgcn_s_setprio(0); } while (0)
#define PG8_WAIT_V(n) asm volatile("s_waitcnt vmcnt(" #n ")" ::: "memory")
#define PG8_WAIT_L(n) asm volatile("s_waitcnt lgkmcnt(" #n ")" ::: "memory")
#define PG8_BAR __builtin_amdgcn_s_barrier()
#define PG8_SCHED __builtin_amdgcn_sched_barrier(0)
    Unit cur, nxt; int ui = 0;
    if (!S.next(0, cur)) return;
    f32x4 acc[2][2][4][2];
#pragma unroll
    for (int a = 0; a < 2; ++a)
#pragma unroll
        for (int b = 0; b < 2; ++b)
#pragma unroll
            for (int m = 0; m < 4; ++m)
#pragma unroll
                for (int n = 0; n < 2; ++n) acc[a][b][m][n] = (f32x4){0.f, 0.f, 0.f, 0.f};
    bf16x8 At[4][2], B0[2][2], B1[2][2];
    const char* cA = (const char*)g.A + (size_t)cur.pm * tstep; const char* cB = (const char*)g.Bt + (size_t)cur.pn * tstep;
    PG8_STAGE(PG8_SB(0, 0), cB, voffB); PG8_STAGE(PG8_SA(0, 0), cA, voffA); PG8_STAGE(PG8_SB(0, 1), cB + hstep, voffB); PG8_STAGE(PG8_SA(0, 1), cA + hstep, voffA);
    if (wr == 1) PG8_BAR;
    PG8_WAIT_V(4); PG8_BAR;
    PG8_STAGE(PG8_SB(1, 0), cB + kstep, voffB); PG8_STAGE(PG8_SA(1, 0), cA + kstep, voffA); PG8_STAGE(PG8_SB(1, 1), cB + hstep + kstep, voffB);
    PG8_WAIT_V(6); PG8_BAR;
    for (;;) {
        const bool has_next = S.next(ui + 1, nxt);
        const char* nA = has_next ? (const char*)g.A + (size_t)nxt.pm * tstep : cA; const char* nB = has_next ? (const char*)g.Bt + (size_t)nxt.pn * tstep : cB;
        int t = 0;
#pragma unroll 1
        for (int seg = 0; seg < 3; ++seg) {
        const int tend = (E.mode == 1) ? (seg == 0 ? 12 : (seg == 1 ? 16 : nt)) : (seg == 0 ? nt : 0);
#pragma unroll 1
        for (; t < tend; t += 2) {
            const bool last = (t == nt - 2);
            const char* a1 = cA + (size_t)(t + 1) * kstep;
            const char* a2 = last ? nA : cA + (size_t)(t + 2) * kstep; const char* b2 = last ? nB : cB + (size_t)(t + 2) * kstep;
            const char* a3 = a2 + kstep; const char* b3 = b2 + kstep;
            PG8_LDB(B0, 0, 0); PG8_SCHED; PG8_LDA(At, 0, 0); PG8_STAGE(PG8_SA(1, 1), a1 + hstep, voffA);
            PG8_WAIT_L(8); PG8_BAR; PG8_WAIT_L(0); PG8_MMA(0, 0, At, B0); PG8_BAR; PG8_SCHED;
            PG8_LDB(B1, 0, 1); PG8_STAGE(PG8_SB(0, 0), b2, voffB);
            PG8_BAR; PG8_WAIT_L(0); PG8_MMA(0, 1, At, B1); PG8_BAR;
            PG8_LDA(At, 0, 1); PG8_STAGE(PG8_SA(0, 0), a2, voffA);
            PG8_BAR; PG8_WAIT_L(0); PG8_MMA(1, 0, At, B0); PG8_BAR; PG8_SCHED;
            PG8_STAGE(PG8_SB(0, 1), b2 + hstep, voffB);
            PG8_WAIT_V(6); PG8_BAR; PG8_MMA(1, 1, At, B1); PG8_BAR;
            PG8_LDB(B0, 1, 0); PG8_SCHED; PG8_LDA(At, 1, 0); PG8_STAGE(PG8_SA(0, 1), a2 + hstep, voffA);
            PG8_WAIT_L(8); PG8_BAR; PG8_WAIT_L(0); PG8_MMA(0, 0, At, B0); PG8_BAR; PG8_SCHED;
            PG8_LDB(B1, 1, 1); PG8_STAGE(PG8_SB(1, 0), b3, voffB);
            PG8_BAR; PG8_WAIT_L(0); PG8_MMA(0, 1, At, B1); PG8_BAR;
            PG8_LDA(At, 1, 1); PG8_STAGE(PG8_SA(1, 0), a3, voffA);
            PG8_BAR; PG8_WAIT_L(0); PG8_MMA(1, 0, At, B0); PG8_BAR; PG8_SCHED;
            PG8_STAGE(PG8_SB(1, 1), b3 + hstep, voffB);
            PG8_WAIT_V(6); PG8_BAR; PG8_MMA(1, 1, At, B1); PG8_BAR;
        }
        if (E.mode == 1 && seg < 2) E.hook(acc, cur, wr, wc, fr, fq, seg);
        }
        if (!E.fuse) E(acc, cur, wr, wc, fr, fq);
        if (!has_next) break;
#pragma unroll
        for (int a = 0; a < 2; ++a)
#pragma unroll
            for (int b = 0; b < 2; ++b)
#pragma unroll
                for (int m = 0; m < 4; ++m)
#pragma unroll
                    for (int n = 0; n < 2; ++n) acc[a][b][m][n] = (f32x4){0.f, 0.f, 0.f, 0.f};
        cur = nxt; cA = nA; cB = nB; ++ui;
    }
    PG8_WAIT_V(0);
    if (wr == 0) PG8_BAR;
    PG8_BAR;
    if (E.fuse) E.fused(acc, cur, wr, wc, fr, fq, (unsigned char*)lds);
#undef PG8_SA
#undef PG8_SB
#undef PG8_STAGE
#undef PG8_LDA
#undef PG8_LDB
#undef PG8_MMA
#undef PG8_WAIT_V
#undef PG8_WAIT_L
#undef PG8_BAR
#undef PG8_SCHED
}
}

struct EpiAny {
    int mode; bool PERM;
    int l; const Params& p; bool fuse;
#define EPI_SETUP() int ll = l; asm volatile("" : "+s"(ll)); unsigned char* const ws = p.ws; bf16_t* const P = (bf16_t*)(ws + W_PROJ); (void)P; \
        const float* const MOD = (const float*)(ws + W_MOD) + ll * 12288; (void)MOD; float* const X = (float*)(ws + W_X); (void)X
    __device__ __forceinline__ void hook(f32x4 (&acc)[2][2][4][2], const pg8::Unit& u, int wr, int wc, int fr, int fq, int which) const {
        EPI_SETUP();
        int row0 = u.pm * 256 + wr * 64 + fr; asm volatile("" : "+v"(row0));
        const int col0 = u.pn * 256 + wc * 32 + 8 * fq;
        const int gc0 = C_GATE + which * 2048 + col0;
        u32x4 gb[2][2][2];
#define HOOK_LD(it, bf) do { const int gr = row0 + ((it) >> 2) * 128 + ((it) & 3) * 16; \
        _Pragma("unroll") for (int bj = 0; bj < 2; ++bj) { gb[bf][bj][0] = *(const u32x4*)(P + pidx(gr, gc0 + bj * 128)); gb[bf][bj][1] = *(const u32x4*)(P + pidx(gr, gc0 + 2048 + bj * 128)); } } while (0)
        HOOK_LD(0, 0);
#pragma unroll
        for (int it = 0; it < 8; ++it) {
            if (it < 7) HOOK_LD(it + 1, (it + 1) & 1);
            const int ai = it >> 2, m = it & 3;
#pragma unroll
            for (int bj = 0; bj < 2; ++bj) {
                const u32x4 ga = gb[it & 1][bj][0], gq = gb[it & 1][bj][1];
#pragma unroll
                for (int n = 0; n < 2; ++n) {
                    f32x4 r = {sigratio(bflo(ga[2 * n]), bflo(gq[2 * n])), sigratio(bfhi(ga[2 * n]), bfhi(gq[2 * n])), sigratio(bflo(ga[2 * n + 1]), bflo(gq[2 * n + 1])), sigratio(bfhi(ga[2 * n + 1]), bfhi(gq[2 * n + 1]))};
                    acc[ai][bj][m][n] *= r;
                }
            }
            asm volatile("" ::: "memory");
        }
#undef HOOK_LD
    }
    __device__ __forceinline__ void fused(f32x4 (&acc)[2][2][4][2], const pg8::Unit& u, int wr, int wc, int fr, int fq, unsigned char* lds) const {
        EPI_SETUP();
        const int tid = tidx(), lane = tid & 63;
        int row0 = u.pm * 256 + wr * 64 + fr; asm volatile("" : "+v"(row0));
        const int col0 = u.pn * 256 + wc * 32 + 8 * fq;
        const float* const xin = (mode == 4 && ll == 0) ? p.in[0] : X;
        const float* const gate = MOD + (mode == 4 ? 4096 : 10240);
        const int site = mode == 4 ? ll : 2;
        const float* const ngain = mode == 4 ? p.in[5] + ll * D : p.in[4] + D;
        const float* const nshift = mode == 4 ? MOD + 6144 : MOD + 12288;
        const float* const nscale = mode == 4 ? MOD + 8192 : MOD + 12288 + 2048;
        float* tab = (float*)lds; float* invtab = (float*)(lds + 4096);
        f32x4 gv[2][2], xb[2][2][2];
#pragma unroll
        for (int bj = 0; bj < 2; ++bj)
#pragma unroll
            for (int n = 0; n < 2; ++n) gv[bj][n] = *(const f32x4*)(gate + col0 + bj * 128 + n * 4);
#define F4_LD(it, bf) do { const float* xp = xin + (size_t)(row0 + ((it) >> 2) * 128 + ((it) & 3) * 16) * D + col0; \
        _Pragma("unroll") for (int bj = 0; bj < 2; ++bj) _Pragma("unroll") for (int n = 0; n < 2; ++n) xb[bf][bj][n] = *(const f32x4*)(xp + bj * 128 + n * 4); } while (0)
        F4_LD(0, 0);
#pragma unroll
        for (int it = 0; it < 8; ++it) {
            if (it < 7) F4_LD(it + 1, (it + 1) & 1);
            const int ai = it >> 2, m = it & 3;
            float* op = X + (size_t)(row0 + ai * 128 + m * 16) * D + col0;
            float ps = 0.f;
#pragma unroll
            for (int bj = 0; bj < 2; ++bj)
#pragma unroll
                for (int n = 0; n < 2; ++n) {
                    const f32x4 xv = xb[it & 1][bj][n] + gv[bj][n] * acc[ai][bj][m][n];
                    *(f32x4*)(op + bj * 128 + n * 4) = xv;
                    acc[ai][bj][m][n] = xv;
                    ps += xv[0] * xv[0] + xv[1] * xv[1] + xv[2] * xv[2] + xv[3] * xv[3];
                }
            ps += shx(ps, 16, lane); ps += shx(ps, 32, lane);
            if (fq == 0) tab[(ai * 128 + wr * 64 + m * 16 + fr) * 4 + wc] = ps;
            asm volatile("" ::: "memory");
        }
#undef F4_LD
        __syncthreads();
        unsigned* const cnt = (unsigned*)(ws + W_FCNT) + (site * 32 + u.pm) * 64;
        unsigned* const slot = (unsigned*)(ws + W_FSLOT) + ((size_t)(site * 32 + u.pm) * 256) * 8;
        if (tid < 256) {
            const f32x4 t4 = *(const f32x4*)(tab + tid * 4);
            __hip_atomic_store(slot + tid * 8 + u.pn, __float_as_uint(t4[0] + t4[1] + t4[2] + t4[3]), __ATOMIC_RELAXED, __HIP_MEMORY_SCOPE_AGENT);
        }
        asm volatile("s_waitcnt vmcnt(0)" ::: "memory");
        __syncthreads();
        if (tid == 0) {
            (void)xb_add(cnt, 1u);
            unsigned sp_ = 0;
            while (xb_ld(cnt) < 8u) { __builtin_amdgcn_s_sleep(1); if (++sp_ > (1u << 22)) break; }
        }
        __syncthreads();
        if (tid < 256) {
            float sum = 0.f;
#pragma unroll
            for (int j = 0; j < 8; ++j) sum += __uint_as_float(xb_ld(slot + tid * 8 + j));
            invtab[tid] = rsqrtf(sum * (1.f / D) + EPS);
        }
        __syncthreads();
        bf16_t* const H = (bf16_t*)(ws + W_H);
        f32x4 cmv[2][2], shv[2][2];
#pragma unroll
        for (int bj = 0; bj < 2; ++bj)
#pragma unroll
            for (int n = 0; n < 2; ++n) {
                const int c = col0 + bj * 128 + n * 4;
                cmv[bj][n] = *(const f32x4*)(ngain + c) * (1.f + *(const f32x4*)(nscale + c)); shv[bj][n] = *(const f32x4*)(nshift + c);
            }
#pragma unroll
        for (int it = 0; it < 8; ++it) {
            const int ai = it >> 2, m = it & 3;
            const float inv = invtab[ai * 128 + wr * 64 + m * 16 + fr];
            bf16_t* hp = H + (size_t)(row0 + ai * 128 + m * 16) * D + col0;
#pragma unroll
            for (int bj = 0; bj < 2; ++bj) {
                const f32x4 y0 = acc[ai][bj][m][0] * inv * cmv[bj][0] + shv[bj][0], y1 = acc[ai][bj][m][1] * inv * cmv[bj][1] + shv[bj][1];
                u32x4 o = {pk2(y0[0], y0[1]), pk2(y0[2], y0[3]), pk2(y1[0], y1[1]), pk2(y1[2], y1[3])};
                *(u32x4*)(hp + bj * 128) = o;
            }
        }
    }
    __device__ __forceinline__ void operator()(const f32x4 (&acc)[2][2][4][2], const pg8::Unit& u, int wr, int wc, int fr, int fq) const {
        EPI_SETUP();
        int row0 = u.pm * 256 + wr * 64 + fr; asm volatile("" : "+v"(row0));
        if (mode == 0) {
            float* const agla = (float*)(ws + W_AGLA);
            const int col0 = u.pn * 256 + wc * 32 + 8 * fq;
#pragma unroll
            for (int ai = 0; ai < 2; ++ai)
#pragma unroll
                for (int m = 0; m < 4; ++m) {
                    const int row = row0 + ai * 128 + m * 16;
                    bf16_t* rp = P + pidx(row, col0);
#pragma unroll
                    for (int bj = 0; bj < 2; ++bj) {
                        const f32x4 v0 = acc[ai][bj][m][0], v1 = acc[ai][bj][m][1];
                        u32x4 o = {pk2(v0[0], v0[1]), pk2(v0[2], v0[3]), pk2(v1[0], v1[1]), pk2(v1[2], v1[3])};
                        *(u32x4*)(rp + (size_t)bj * T * 128) = o;
                    }
                    if (u.pn == 30 && wc == 0 && fq < 2) { float* a = agla + (size_t)row * 16 + 8 * fq; *(f32x4*)a = acc[ai][0][m][0]; *(f32x4*)(a + 4) = acc[ai][0][m][1]; }
                }
        } else if (mode == 1) {
            bf16_t* const YB = (bf16_t*)(ws + W_YB);
            const int col0 = u.pn * 256 + wc * 32 + 8 * fq;
            const int gc2 = C_GATE + 4096 + col0;
            u32x4 gb[2][2];
#define M1_LD(it, bf) do { const int gr = row0 + ((it) >> 2) * 128 + ((it) & 3) * 16; \
            _Pragma("unroll") for (int bj = 0; bj < 2; ++bj) gb[bf][bj] = *(const u32x4*)(P + pidx(gr, gc2 + bj * 128)); } while (0)
            M1_LD(0, 0);
#pragma unroll
            for (int it = 0; it < 8; ++it) {
                if (it < 7) M1_LD(it + 1, (it + 1) & 1);
                const int ai = it >> 2, m = it & 3, row = row0 + ai * 128 + m * 16;
#pragma unroll
                for (int bj = 0; bj < 2; ++bj) {
                    const u32x4 gw = gb[it & 1][bj];
                    const f32x4 a0 = acc[ai][bj][m][0], a1 = acc[ai][bj][m][1];
                    u32x4 o = {pk2(sigc(bflo(gw[0])) * a0[0], sigc(bfhi(gw[0])) * a0[1]), pk2(sigc(bflo(gw[1])) * a0[2], sigc(bfhi(gw[1])) * a0[3]),
                               pk2(sigc(bflo(gw[2])) * a1[0], sigc(bfhi(gw[2])) * a1[1]), pk2(sigc(bflo(gw[3])) * a1[2], sigc(bfhi(gw[3])) * a1[3])};
                    *(u32x4*)(YB + (size_t)row * D + col0 + bj * 128) = o;
                }
                asm volatile("" ::: "memory");
            }
#undef M1_LD
        } else if (mode == 4 || mode == 6) {
            const float* const xin = (mode == 4 && ll == 0) ? p.in[0] : X;
            const float* const gate = MOD + (mode == 4 ? 4096 : 10240);
            float* const out = (mode == 6 && ll == 1) ? p.out : X;
            const int col0 = u.pn * 256 + wc * 32 + 8 * fq;
            f32x4 gv[2][2], xb[2][2][2];
#pragma unroll
            for (int bj = 0; bj < 2; ++bj)
#pragma unroll
                for (int n = 0; n < 2; ++n) gv[bj][n] = *(const f32x4*)(gate + col0 + bj * 128 + n * 4);
#define M4_LD(it, bf) do { const float* xp = xin + (size_t)(row0 + ((it) >> 2) * 128 + ((it) & 3) * 16) * D + col0; \
            _Pragma("unroll") for (int bj = 0; bj < 2; ++bj) _Pragma("unroll") for (int n = 0; n < 2; ++n) xb[bf][bj][n] = *(const f32x4*)(xp + bj * 128 + n * 4); } while (0)
            M4_LD(0, 0);
#pragma unroll
            for (int it = 0; it < 8; ++it) {
                if (it < 7) M4_LD(it + 1, (it + 1) & 1);
                const int ai = it >> 2, m = it & 3;
                float* op = out + (size_t)(row0 + ai * 128 + m * 16) * D + col0;
#pragma unroll
                for (int bj = 0; bj < 2; ++bj)
#pragma unroll
                    for (int n = 0; n < 2; ++n) { const f32x4 xo = xb[it & 1][bj][n] + gv[bj][n] * acc[ai][bj][m][n]; if (out == p.out) __builtin_nontemporal_store(xo, (f32x4*)(op + bj * 128 + n * 4)); else *(f32x4*)(op + bj * 128 + n * 4) = xo; }
                asm volatile("" ::: "memory");
            }
#undef M4_LD
        } else {
            const int col0 = u.pn * 128 + wc * 32 + 8 * fq;
#pragma unroll
            for (int ai = 0; ai < 2; ++ai)
#pragma unroll
                for (int m = 0; m < 4; ++m) {
                    const int row = row0 + ai * 128 + m * 16;
                    float h[8];
#pragma unroll
                    for (int n = 0; n < 2; ++n)
#pragma unroll
                        for (int j = 0; j < 4; ++j) h[n * 4 + j] = siluf_(acc[ai][0][m][n][j]) * acc[ai][1][m][n][j];
                    u32x4 o = {pk2(h[0], h[1]), pk2(h[2], h[3]), pk2(h[4], h[5]), pk2(h[6], h[7])};
                    *(u32x4*)(P + (size_t)row * DFF + col0) = o;
                }
        }
    }
};

__device__ __forceinline__ void mod_item(const Params& p, int item, unsigned char* lds) {
    const int tid = tidx();
    float* sc = (float*)lds; float* part = (float*)(lds + 8192);
    const int l = item >> 7, j0 = (item & 127) * 96;
    const float* c = p.in[1]; const float* w = p.in[2] + (size_t)l * D * 12288; const float* b = p.in[3] + l * 12288;
    float* MOD = (float*)(p.ws + W_MOD);
    for (int i = tid; i < D; i += 512) { const float v = c[i]; sc[i] = siluf_(v); }
    __syncthreads();
    const int cgp = tid % 24, ks = tid / 24;
    if (ks < 21) {
        f32x4 a = {0.f, 0.f, 0.f, 0.f};
#pragma unroll 8
        for (int k = ks; k < D; k += 21) { const f32x4 wv = __builtin_nontemporal_load((const f32x4*)(w + (size_t)k * 12288 + j0 + cgp * 4)); a += sc[k] * wv; }
        *(f32x4*)(part + ks * 96 + cgp * 4) = a;
    }
    __syncthreads();
    if (tid < 96) { float s = b[j0 + tid]; for (int q = 0; q < 21; ++q) s += part[q * 96 + tid]; MOD[l * 12288 + j0 + tid] = s; }
    __syncthreads();
}

struct ConvDesc { const float* src; bf16_t* dst; int Nsrc, nvalid, K; };
constexpr int CV_PER_LAYER = 4384;
__device__ __forceinline__ ConvDesc conv_desc(const Params& p, int item) {
    const int l = item / CV_PER_LAYER; int r = item % CV_PER_LAYER;
    unsigned char* wl = p.ws + (size_t)l * SZ_WL;
    ConvDesc d; d.nvalid = 128;
    if (r < 1760) { const int kt = r / 110, nt = r % 110; int nv = NIN - nt * 128; d.nvalid = nv < 0 ? 0 : (nv > 128 ? 128 : nv); d.Nsrc = NIN; d.K = D;
        d.src = p.in[6] + (size_t)l * D * NIN + (size_t)(kt * 128) * NIN + nt * 128; d.dst = (bf16_t*)(wl + O_WIN) + (size_t)(nt * 128) * D + kt * 128; return d; }
    r -= 1760;
    if (r < 96) { const int kt = r >> 4, nt = r & 15; d.Nsrc = D; d.K = D;
        d.src = p.in[14] + (size_t)l * 768 * D + (size_t)(kt * 128) * D + nt * 128; d.dst = (bf16_t*)(wl + O_WBR) + (size_t)(nt * 128) * D + kt * 128; return d; }
    r -= 96;
    if (r < 32) { const int kt = r >> 4, nt = r & 15; d.Nsrc = D; d.K = D;
        d.src = p.in[15] + (size_t)l * 256 * D + (size_t)(kt * 128) * D + nt * 128; d.dst = (bf16_t*)(wl + O_WBR) + (size_t)(nt * 128) * D + 768 + kt * 128; return d; }
    r -= 32;
    if (r < 128) { const int kt = r >> 4, nt = r & 15; d.Nsrc = D; d.K = D;
        d.src = p.in[16] + (size_t)l * 1024 * D + (size_t)(kt * 128) * D + nt * 128; d.dst = (bf16_t*)(wl + O_WBR) + (size_t)(nt * 128) * D + 1024 + kt * 128; return d; }
    r -= 128;
    if (r < 256) { const int kt = r >> 4, nt = r & 15; d.Nsrc = D; d.K = D;
        d.src = p.in[17] + (size_t)l * D * D + (size_t)(kt * 128) * D + nt * 128; d.dst = (bf16_t*)(wl + O_WOUT) + (size_t)(nt * 128) * D + kt * 128; return d; }
    r -= 256;
    if (r < 1408) { const int kt = r / 88, nt = r % 88; const int pn = nt >> 1, bj = nt & 1; d.Nsrc = 2 * DFF; d.K = D;
        d.src = p.in[18] + (size_t)l * D * 2 * DFF + (size_t)(kt * 128) * (2 * DFF) + bj * DFF + pn * 128; d.dst = (bf16_t*)(wl + O_WFI) + (size_t)(nt * 128) * D + kt * 128; return d; }
    r -= 1408;
    { const int kt = r >> 4, nt = r & 15; d.Nsrc = D; d.K = DFF;
      d.src = p.in[19] + (size_t)l * DFF * D + (size_t)(kt * 128) * D + nt * 128; d.dst = (bf16_t*)(wl + O_WFO) + (size_t)(nt * 128) * DFF + kt * 128; return d; }
}
__device__ __forceinline__ void conv_load(const ConvDesc& d, int tid, f32x4 (&v)[8]) {
#pragma unroll
    for (int i = 0; i < 8; ++i) {
        const int idx = tid + 512 * i, row = idx >> 5, c4 = idx & 31;
        v[i] = (f32x4){0.f, 0.f, 0.f, 0.f};
        if (c4 * 4 < d.nvalid) v[i] = __builtin_nontemporal_load((const f32x4*)(d.src + (size_t)row * d.Nsrc + c4 * 4));
    }
}
__device__ __forceinline__ void conv_phase(const Params& p, unsigned char* lds, int lo1, int n1, int lo2, int n2, int worker, int nworkers) {
    const int tid = tidx(), lane = tid & 63, w = tid >> 6;
    float* st = (float*)lds;
    const int ntot = n1 + n2;
    int v = worker;
    if (v >= ntot) return;
    ConvDesc d = conv_desc(p, v < n1 ? lo1 + v : lo2 + v - n1);
    f32x4 x4[8];
    conv_load(d, tid, x4);
    for (;;) {
#pragma unroll
        for (int i = 0; i < 8; ++i) {
            const int idx = tid + 512 * i; float* sp = st + (idx >> 5) * 129 + (idx & 31) * 4;
            sp[0] = x4[i][0]; sp[1] = x4[i][1]; sp[2] = x4[i][2]; sp[3] = x4[i][3];
        }
        __syncthreads();
        const ConvDesc dc = d;
        const int nx = v + nworkers; const bool more = nx < ntot;
        if (more) { d = conv_desc(p, nx < n1 ? lo1 + nx : lo2 + nx - n1); conv_load(d, tid, x4); }
        unsigned* dp = (unsigned*)(dc.dst + (size_t)(16 * w) * dc.K) + lane;
        const float* rp = st + (2 * lane) * 129 + 16 * w;
#pragma unroll
        for (int q = 0; q < 16; ++q) dp[(size_t)q * (dc.K >> 1)] = pk2(rp[q], rp[129 + q]);
        __syncthreads();
        if (!more) break;
        v = nx;
    }
}
constexpr int CV_DEF_A = 256, CV_DEF_B = 1280, CV_DEF_C = 3680, CV_DEF_D = 3936;

__device__ __forceinline__ void norm_phase(const float* __restrict__ xin, const float* __restrict__ gain, const float* __restrict__ shift, const float* __restrict__ scale, bf16_t* __restrict__ H) {
    const int tid = tidx(), lane = tid & 63, gw = bidx() * 8 + (tid >> 6), nw = gridDim.x * 8;
    for (int row = gw; row < T; row += nw) {
        const float* xr = xin + (size_t)row * D;
        f32x4 v[8]; float ss = 0.f;
#pragma unroll
        for (int i = 0; i < 8; ++i) { v[i] = *(const f32x4*)(xr + i * 256 + lane * 4); ss += v[i][0] * v[i][0] + v[i][1] * v[i][1] + v[i][2] * v[i][2] + v[i][3] * v[i][3]; }
#pragma unroll
        for (int o = 32; o > 0; o >>= 1) ss += shx(ss, o, lane);
        const float inv = rsqrtf(ss * (1.f / D) + EPS);
#pragma unroll
        for (int i = 0; i < 8; ++i) {
            const int c = i * 256 + lane * 4;
            const f32x4 g = *(const f32x4*)(gain + c), sh = *(const f32x4*)(shift + c), sc = *(const f32x4*)(scale + c);
            const f32x4 y = v[i] * inv * g * (1.f + sc) + sh;
            u32x2 o = {pk2(y[0], y[1]), pk2(y[2], y[3])};
            *(u32x2*)(H + (size_t)row * D + c) = o;
        }
    }
}

template <int nkeys> __device__ __forceinline__ void stage_vt(bf16_t* VT, int pitch, const bf16_t* P, int r0, int rstride, int col, int nch) {
    const int tid = tidx();
    for (int idx = tid; idx < nkeys * nch; idx += 512) {
        const int key = idx % nkeys, ch = idx / nkeys;
        const u32x4 raw = *(const u32x4*)(P + pidx(r0 + key * rstride, col + ch * 8));
        bf16_t* d = VT + (ch * 8) * pitch + key;
        d[0] = (bf16_t)(raw[0] & 0xffff); d[pitch] = (bf16_t)(raw[0] >> 16); d[2 * pitch] = (bf16_t)(raw[1] & 0xffff); d[3 * pitch] = (bf16_t)(raw[1] >> 16);
        d[4 * pitch] = (bf16_t)(raw[2] & 0xffff); d[5 * pitch] = (bf16_t)(raw[2] >> 16); d[6 * pitch] = (bf16_t)(raw[3] & 0xffff); d[7 * pitch] = (bf16_t)(raw[3] >> 16);
    }
}
__device__ __forceinline__ void stage_rows128_norm(bf16_t* dst, const bf16_t* P, int r0, int rstride, int col, const float* __restrict__ gain, float qs) {
    const int tid = tidx(), lane = tid & 63;
    const f32x4 g0 = *(const f32x4*)(gain + (tid & 15) * 8), g1 = *(const f32x4*)(gain + (tid & 15) * 8 + 4);
#pragma unroll
    for (int i = 0; i < 4; ++i) {
        const int idx = tid + 512 * i, r = idx >> 4, ch = idx & 15;
        const u32x4 raw = *(const u32x4*)(P + pidx(r0 + r * rstride, col + ch * 8));
        float v[8] = {bflo(raw[0]), bfhi(raw[0]), bflo(raw[1]), bfhi(raw[1]), bflo(raw[2]), bfhi(raw[2]), bflo(raw[3]), bfhi(raw[3])};
        float ss = 0.f;
#pragma unroll
        for (int j = 0; j < 8; ++j) ss += v[j] * v[j];
        ss += shx(ss, 1, lane); ss += shx(ss, 2, lane); ss += shx(ss, 4, lane); ss += shx(ss, 8, lane);
        const float inv = rsqrtf(ss * (1.f / 128.f) + EPS) * qs;
        u32x4 o = {pk2(v[0] * inv * g0[0], v[1] * inv * g0[1]), pk2(v[2] * inv * g0[2], v[3] * inv * g0[3]),
                   pk2(v[4] * inv * g1[0], v[5] * inv * g1[1]), pk2(v[6] * inv * g1[2], v[7] * inv * g1[3])};
        *(u32x4*)(dst + r * 136 + ch * 8) = o;
    }
}
__device__ __forceinline__ void pv_tile(f32x4 (&oacc)[8], const bf16_t* VT, int pitch, int koff, const float (&w)[4][4], int fr, int fq) {
    bf16x8 pf[2];
#pragma unroll
    for (int kb = 0; kb < 2; ++kb) pf[kb] = mk8(pk2(w[2 * kb][0], w[2 * kb][1]), pk2(w[2 * kb][2], w[2 * kb][3]), pk2(w[2 * kb + 1][0], w[2 * kb + 1][1]), pk2(w[2 * kb + 1][2], w[2 * kb + 1][3]));
#pragma unroll
    for (int db = 0; db < 8; ++db)
#pragma unroll
        for (int kb = 0; kb < 2; ++kb) {
            const bf16_t* vp = VT + (16 * db + fr) * pitch + koff + 32 * kb + 4 * fq;
            const u32x2 lo = *(const u32x2*)vp, hi = *(const u32x2*)(vp + 16);
            oacc[db] = mfma16(mk8(lo[0], lo[1], hi[0], hi[1]), pf[kb], oacc[db]);
        }
}

constexpr int AT_Q = 0, AT_BUF = 34816, AT_BUFSZ = 17408 + 18432, AT_VOFF = 17408, AT_F = AT_BUF + 2 * AT_BUFSZ;
struct TileRegs { u32x4 k[2], v[2]; };
__device__ __forceinline__ void tile_load(TileRegs& t, const bf16_t* P, int r0, int rstride, int kcol, int vcol, int tid) {
#pragma unroll
    for (int i = 0; i < 2; ++i) {
        const int idx = tid + 512 * i;
        t.k[i] = *(const u32x4*)(P + pidx(r0 + (idx >> 4) * rstride, kcol + (idx & 15) * 8));
        t.v[i] = *(const u32x4*)(P + pidx(r0 + (idx & 63) * rstride, vcol + (idx >> 6) * 8));
    }
}
__device__ __forceinline__ void tile_write(const TileRegs& t, unsigned char* buf, const f32x4& g0, const f32x4& g1, int tid, int lane) {
    bf16_t* Ks = (bf16_t*)buf; bf16_t* VT = (bf16_t*)(buf + AT_VOFF);
#pragma unroll
    for (int i = 0; i < 2; ++i) {
        const int idx = tid + 512 * i, r = idx >> 4, ch = idx & 15;
        const u32x4 raw = t.k[i];
        float v[8] = {bflo(raw[0]), bfhi(raw[0]), bflo(raw[1]), bfhi(raw[1]), bflo(raw[2]), bfhi(raw[2]), bflo(raw[3]), bfhi(raw[3])};
        float ss = 0.f;
#pragma unroll
        for (int j = 0; j < 8; ++j) ss += v[j] * v[j];
        ss += shx(ss, 1, lane); ss += shx(ss, 2, lane); ss += shx(ss, 4, lane); ss += shx(ss, 8, lane);
        const float inv = rsqrtf(ss * (1.f / 128.f) + EPS);
        u32x4 o = {pk2(v[0] * inv * g0[0], v[1] * inv * g0[1]), pk2(v[2] * inv * g0[2], v[3] * inv * g0[3]),
                   pk2(v[4] * inv * g1[0], v[5] * inv * g1[1]), pk2(v[6] * inv * g1[2], v[7] * inv * g1[3])};
        *(u32x4*)(Ks + r * 136 + ch * 8) = o;
        const u32x4 rv = t.v[i];
        bf16_t* d = VT + ((idx >> 6) * 8) * 72 + (idx & 63);
        d[0] = (bf16_t)(rv[0] & 0xffff); d[72] = (bf16_t)(rv[0] >> 16); d[144] = (bf16_t)(rv[1] & 0xffff); d[216] = (bf16_t)(rv[1] >> 16);
        d[288] = (bf16_t)(rv[2] & 0xffff); d[360] = (bf16_t)(rv[2] >> 16); d[432] = (bf16_t)(rv[3] & 0xffff); d[504] = (bf16_t)(rv[3] >> 16);
    }
}

__device__ __forceinline__ void sb_item(const Params& p, int item, int l, unsigned char* lds) {
    const int tid = tidx(), w = tid >> 6, lane = tid & 63, fr = lane & 15, fq = lane >> 4;
    const bf16_t* P = (const bf16_t*)(p.ws + W_PROJ);
    bf16_t* OSB = (bf16_t*)(p.ws + W_OCAT);
    const int head = item >> 6, I = 63 - (item & 63);
    bf16_t* Qs = (bf16_t*)(lds + AT_Q); float* flags = (float*)(lds + AT_F);
    const float* gq = p.in[7] + l * 128; const float* gk = p.in[8] + l * 128;
    const f32x4 gk0 = *(const f32x4*)(gk + (tid & 15) * 8), gk1 = *(const f32x4*)(gk + (tid & 15) * 8 + 4);
    const int kcol = C_KSB + head * 128, vcol = C_VSB + head * 128;
    __syncthreads();
    TileRegs tr;
    int J = 2 * I + 1;
    tile_load(tr, P, 64 * J, 1, kcol, vcol, tid);
    stage_rows128_norm(Qs, P, 128 * I, 1, C_QSB + head * 128, gq, 0.08838834764831845f);
    tile_write(tr, lds + AT_BUF, gk0, gk1, tid, lane);
    tile_load(tr, P, 64 * (J - 1), 1, kcol, vcol, tid);
    __syncthreads();
    bf16x8 qf[4];
#pragma unroll
    for (int ks = 0; ks < 4; ++ks) qf[ks] = *(const bf16x8*)(Qs + (16 * w + fr) * 136 + 32 * ks + 8 * fq);
    f32x4 oacc[8];
#pragma unroll
    for (int db = 0; db < 8; ++db) oacc[db] = (f32x4){0.f, 0.f, 0.f, 0.f};
    float R = 1.f;
    const int tq = 128 * I + 16 * w + fr;
    constexpr float SB_EXIT = 1e-9f;
    int cur = 0;
    for (;;) {
        const bf16_t* Ks = (const bf16_t*)(lds + AT_BUF + cur * AT_BUFSZ); const bf16_t* VT = (const bf16_t*)(lds + AT_BUF + cur * AT_BUFSZ + AT_VOFF);
        const bool allmasked = 64 * J >= 128 * I + 16 * w + 15;
        if (!allmasked) {
            f32x4 s[4];
#pragma unroll
            for (int b = 0; b < 4; ++b) {
                s[b] = (f32x4){0.f, 0.f, 0.f, 0.f};
#pragma unroll
                for (int ks = 0; ks < 4; ++ks) s[b] = mfma16(*(const bf16x8*)(Ks + (16 * b + fr) * 136 + 32 * ks + 8 * fq), qf[ks], s[b]);
            }
            float beta[4][4], omb[4][4], lat[4], tot[4], wgt[4][4];
#pragma unroll
            for (int b = 0; b < 4; ++b) {
#pragma unroll
                for (int r = 0; r < 4; ++r) {
                    const int key = 64 * J + 16 * b + 4 * fq + r;
                    const float z = fminf(fmaxf(s[b][r], -80.f), 80.f);
                    const float e = __expf(-z), bt = __builtin_amdgcn_rcpf(1.f + e);
                    const bool valid = key < tq;
                    beta[b][r] = valid ? bt : 0.f; omb[b][r] = valid ? e * bt : 1.f;
                }
                const float g = omb[b][0] * omb[b][1] * omb[b][2] * omb[b][3];
                const float g1 = shx(g, 16, lane), g2 = shx(g, 32, lane), g3 = shx(g, 48, lane);
                lat[b] = fq == 0 ? g1 * g2 * g3 : (fq == 1 ? g2 * g3 : (fq == 2 ? g1 : 1.f));
                tot[b] = g * g1 * g2 * g3;
            }
            float cb = R;
#pragma unroll
            for (int b = 3; b >= 0; --b) {
                float c = cb * lat[b];
#pragma unroll
                for (int r = 3; r >= 0; --r) { wgt[b][r] = beta[b][r] * c; c *= omb[b][r]; }
                cb *= tot[b];
            }
            R = cb;
            pv_tile(oacc, VT, 72, 0, wgt, fr, fq);
        }
        float rm = R;
#pragma unroll
        for (int o = 32; o > 0; o >>= 1) rm = fmaxf(rm, shx(rm, o, lane));
        if (lane == 0) flags[cur * 8 + w] = rm;
        if (J == 0) break;
        tile_write(tr, lds + AT_BUF + (cur ^ 1) * AT_BUFSZ, gk0, gk1, tid, lane);
        if (J >= 2) tile_load(tr, P, 64 * (J - 2), 1, kcol, vcol, tid);
        __syncthreads();
        float mx = 0.f;
#pragma unroll
        for (int q = 0; q < 8; ++q) mx = fmaxf(mx, flags[cur * 8 + q]);
        if (mx < SB_EXIT) break;
        cur ^= 1; --J;
    }
    bf16_t* op = OSB + (size_t)tq * D + head * 128 + 4 * fq;
#pragma unroll
    for (int db = 0; db < 8; ++db) { u32x2 o = {pk2(oacc[db][0], oacc[db][1]), pk2(oacc[db][2], oacc[db][3])}; *(u32x2*)(op + 16 * db) = o; }
}

__device__ __forceinline__ void dil_item(const Params& p, int item, int l, unsigned char* lds) {
    const int tid = tidx(), w = tid >> 6, lane = tid & 63, fr = lane & 15, fq = lane >> 4;
    const bf16_t* P = (const bf16_t*)(p.ws + W_PROJ);
    float* ODG = (float*)(p.ws + W_ODG); float* LSE = (float*)(p.ws + W_LSE);
    const int g = item >> 7, rem = item & 127, hh = rem >> 6, s6 = rem & 63;
    const int r = g == 0 ? 1 : (g == 1 ? 4 : 16), nb = 64 / r, rho = s6 / nb, n = s6 % nb;
    const int head = 2 * g + hh;
    const float slope = exp2f(-8.f * (float)(head + 1) / 6.f) * (float)r;
    bf16_t* Qs = (bf16_t*)(lds + AT_Q);
    const float* gq = p.in[9] + l * 128; const float* gk = p.in[10] + l * 128;
    const f32x4 gk0 = *(const f32x4*)(gk + (tid & 15) * 8), gk1 = *(const f32x4*)(gk + (tid & 15) * 8 + 4);
    const int kcol = C_KDIL + head * 128, vcol = C_VDIL + head * 128;
    __syncthreads();
    TileRegs tr;
    int c = n == 0 ? 2 : 0;
    tile_load(tr, P, (128 * (n - 1) + 64 * c) * r + rho, r, kcol, vcol, tid);
    stage_rows128_norm(Qs, P, (128 * n) * r + rho, r, C_QDIL + head * 128, gq, 0.08838834764831845f);
    tile_write(tr, lds + AT_BUF, gk0, gk1, tid, lane);
    tile_load(tr, P, (128 * (n - 1) + 64 * (c + 1)) * r + rho, r, kcol, vcol, tid);
    __syncthreads();
    bf16x8 qf[4];
#pragma unroll
    for (int ks = 0; ks < 4; ++ks) qf[ks] = *(const bf16x8*)(Qs + (16 * w + fr) * 136 + 32 * ks + 8 * fq);
    f32x4 oacc[8];
#pragma unroll
    for (int db = 0; db < 8; ++db) oacc[db] = (f32x4){0.f, 0.f, 0.f, 0.f};
    float lsum = 0.f;
    const int iq = 16 * w + fr;
    int cur = 0;
    for (;;) {
        const bf16_t* Ks = (const bf16_t*)(lds + AT_BUF + cur * AT_BUFSZ); const bf16_t* VT = (const bf16_t*)(lds + AT_BUF + cur * AT_BUFSZ + AT_VOFF);
        const int dmax = 128 + 16 * w + 15 - 64 * c, dmin = 128 + 16 * w - 64 * c - 63;
        if (!(dmax < 0 || dmin > 128)) {
            float wgt[4][4];
#pragma unroll
            for (int b = 0; b < 4; ++b) {
                f32x4 sc = {0.f, 0.f, 0.f, 0.f};
#pragma unroll
                for (int ks = 0; ks < 4; ++ks) sc = mfma16(*(const bf16x8*)(Ks + (16 * b + fr) * 136 + 32 * ks + 8 * fq), qf[ks], sc);
#pragma unroll
                for (int q = 0; q < 4; ++q) {
                    const int delta = 128 + iq - 64 * c - (16 * b + 4 * fq + q);
                    const bool valid = delta >= 0 && delta <= 128;
                    const float pe = valid ? __expf(sc[q] - slope * (float)delta) : 0.f;
                    wgt[b][q] = pe; lsum += pe;
                }
            }
            pv_tile(oacc, VT, 72, 0, wgt, fr, fq);
        }
        if (c == 3) break;
        tile_write(tr, lds + AT_BUF + (cur ^ 1) * AT_BUFSZ, gk0, gk1, tid, lane);
        if (c + 2 <= 3) tile_load(tr, P, (128 * (n - 1) + 64 * (c + 2)) * r + rho, r, kcol, vcol, tid);
        __syncthreads();
        cur ^= 1; ++c;
    }
    lsum += shx(lsum, 16, lane); lsum += shx(lsum, 32, lane);
    const float inv = 1.f / lsum;
    const int t = (128 * n + iq) * r + rho;
    float* op = ODG + ((size_t)g * T + t) * 256 + hh * 128 + 4 * fq;
#pragma unroll
    for (int db = 0; db < 8; ++db) *(f32x4*)(op + 16 * db) = oacc[db] * inv;
    if (fq == 0) LSE[(size_t)(g * 2 + hh) * T + t] = __logf(lsum);
}

__device__ __forceinline__ void gla1_item(const Params& p, int item, int l, unsigned char* lds) {
    const int tid = tidx(), w = tid >> 6, lane = tid & 63, fr = lane & 15, fq = lane >> 4;
    const bf16_t* P = (const bf16_t*)(p.ws + W_PROJ);
    const float* agla = (const float*)(p.ws + W_AGLA);
    float* DL = (float*)(p.ws + W_DL); bf16_t* U = (bf16_t*)(p.ws + W_U); float* CUM = (float*)(p.ws + W_CUM);
    const float* wa = p.in[11] + (size_t)l * 16 * 512; const float* ba = p.in[12] + l * 512;
    const int h = item >> 7, n = item & 127, t0 = 64 * n;
    float* cum = (float*)lds; bf16_t* Kr = (bf16_t*)(lds + 32768); bf16_t* KT = (bf16_t*)(lds + 50176); bf16_t* VT = (bf16_t*)(lds + 68608); float* segt = (float*)(lds + 105472);
    __syncthreads();
    {
        const int d = tid & 127, c0 = tid >> 7;
        float wv[16];
#pragma unroll
        for (int q = 0; q < 16; ++q) wv[q] = wa[q * 512 + h * 128 + d];
        const float bias = ba[h * 128 + d];
#pragma unroll 4
        for (int i = 0; i < 16; ++i) {
            const int c = c0 + 4 * i;
            const float* ar = agla + (size_t)(t0 + c) * 16;
            float a = bias;
#pragma unroll
            for (int q4 = 0; q4 < 4; ++q4) { const f32x4 t4 = *(const f32x4*)(ar + q4 * 4); a += t4[0] * wv[q4 * 4] + t4[1] * wv[q4 * 4 + 1] + t4[2] * wv[q4 * 4 + 2] + t4[3] * wv[q4 * 4 + 3]; }
            const float ls = fminf(a, 0.f) - __logf(1.f + __expf(-fabsf(a)));
            cum[c * 128 + d] = ls * (1.f / 16.f);
        }
    }
    for (int idx = tid; idx < 1024; idx += 512) {
        const int r = idx >> 4, ch = idx & 15;
        *(u32x4*)(Kr + r * 136 + ch * 8) = *(const u32x4*)(P + pidx(t0 + r, C_KG + h * 128 + ch * 8));
    }
    stage_vt<64>(VT, 72, P, t0, 1, C_VG + h * 256, 32);
    __syncthreads();
    {
        const int d = tid & 127, sg = tid >> 7;
        float v[16]; float run = 0.f;
#pragma unroll
        for (int i = 0; i < 16; ++i) { run += cum[(16 * sg + i) * 128 + d]; v[i] = run; }
        segt[sg * 128 + d] = run;
        __syncthreads();
        float off = 0.f;
#pragma unroll
        for (int q = 0; q < 3; ++q) off += (q < sg) ? segt[q * 128 + d] : 0.f;
#pragma unroll
        for (int i = 0; i < 16; ++i) { const float c = v[i] + off; cum[(16 * sg + i) * 128 + d] = c; CUM[(size_t)(t0 + 16 * sg + i) * 512 + h * 128 + d] = c; }
        if (sg == 3) DL[(size_t)(h * 128 + n) * 128 + d] = __expf(v[15] + off);
    }
    __syncthreads();
    for (int idx = tid; idx < 1024; idx += 512) {
        const int key = idx & 63, ch = idx >> 6;
        const u32x4 raw = *(const u32x4*)(Kr + key * 136 + ch * 8);
        const float kv[8] = {bflo(raw[0]), bfhi(raw[0]), bflo(raw[1]), bfhi(raw[1]), bflo(raw[2]), bfhi(raw[2]), bflo(raw[3]), bfhi(raw[3])};
#pragma unroll
        for (int e = 0; e < 8; ++e) {
            const int d = ch * 8 + e;
            const float f = __expf(cum[63 * 128 + d] - cum[key * 128 + d]);
            KT[d * 72 + key] = (bf16_t)(pk2(kv[e] * f, 0.f) & 0xffff);
        }
    }
    __syncthreads();
    bf16x8 kf[2];
#pragma unroll
    for (int ks = 0; ks < 2; ++ks) kf[ks] = *(const bf16x8*)(KT + (16 * w + fr) * 72 + 32 * ks + 8 * fq);
    bf16_t* up = U + ((size_t)(h * 128 + n) * 256 + fr) * 128 + 16 * w + 4 * fq;
#pragma unroll
    for (int eb = 0; eb < 16; ++eb) {
        f32x4 a = {0.f, 0.f, 0.f, 0.f};
#pragma unroll
        for (int ks = 0; ks < 2; ++ks) a = mfma16(kf[ks], *(const bf16x8*)(VT + (16 * eb + fr) * 72 + 32 * ks + 8 * fq), a);
        u32x2 o = {pk2(a[0], a[1]), pk2(a[2], a[3])};
        *(u32x2*)(up + (size_t)(16 * eb) * 128) = o;
    }
}

__device__ __forceinline__ void gla2_phase(const Params& p) {
    const float* DL = (const float*)(p.ws + W_DL); const bf16_t* U = (const bf16_t*)(p.ws + W_U); bf16_t* SP = (bf16_t*)(p.ws + W_SP);
    const int total = gridDim.x * 512;
    for (int idx = bidx() * 512 + tidx(); idx < 4 * 32768; idx += total) {
        const int h = idx >> 15, ed = idx & 32767, d = ed & 127;
        const bf16_t* up = U + (size_t)h * 128 * 32768 + ed; bf16_t* sp = SP + (size_t)h * 128 * 32768 + ed; const float* dp = DL + (size_t)h * 128 * 128 + d;
        float S = 0.f;
        for (int n0 = 0; n0 < 128; n0 += 16) {
            float tv[16], dv[16];
#pragma unroll
            for (int q = 0; q < 16; ++q) { tv[q] = bf1(up[(size_t)(n0 + q) * 32768]); dv[q] = dp[(n0 + q) * 128]; }
#pragma unroll
            for (int q = 0; q < 16; ++q) { sp[(size_t)(n0 + q) * 32768] = (bf16_t)(pk2(S, 0.f) & 0xffff); S = dv[q] * S + tv[q]; }
        }
    }
}

__device__ __forceinline__ void gla3_item(const Params& p, int item, int l, unsigned char* lds) {
    const int tid = tidx(), w = tid >> 6, lane = tid & 63, fr = lane & 15, fq = lane >> 4;
    const bf16_t* P = (const bf16_t*)(p.ws + W_PROJ);
    const float* cumg = (const float*)(p.ws + W_CUM);
    bf16_t* OG = (bf16_t*)(p.ws + W_OCAT) + 1024;
    const float* ogain = p.in[13] + l * 256;
    const int h = item >> 7, n = item & 127, t0 = 64 * n;
    float* cum = (float*)lds; bf16_t* ST = (bf16_t*)lds;
    bf16_t* Qp = (bf16_t*)(lds + 69632); bf16_t* Kp = (bf16_t*)(lds + 87040); bf16_t* VT = (bf16_t*)(lds + 104448);
    float* c31 = (float*)(lds + 141312); float* ssq = (float*)(lds + 141824);
    __syncthreads();
#pragma unroll
    for (int i = 0; i < 4; ++i) { const int idx = tid + 512 * i, c = idx >> 5, d4 = idx & 31; *(f32x4*)(cum + c * 128 + d4 * 4) = *(const f32x4*)(cumg + (size_t)(t0 + c) * 512 + h * 128 + d4 * 4); }
    u32x4 rq[2], rk[2];
#pragma unroll
    for (int i = 0; i < 2; ++i) {
        const int idx = tid + 512 * i, c = idx >> 4, ch = idx & 15;
        rq[i] = *(const u32x4*)(P + pidx(t0 + c, C_QG + h * 128 + ch * 8));
        rk[i] = *(const u32x4*)(P + pidx(t0 + c, C_KG + h * 128 + ch * 8));
    }
    stage_vt<64>(VT, 72, P, t0, 1, C_VG + h * 256, 32);
    __syncthreads();
    const bf16_t* sp = (const bf16_t*)(p.ws + W_SP) + (size_t)(h * 128 + n) * 32768;
    u32x4 sv[8];
#pragma unroll
    for (int i = 0; i < 8; ++i) { const int idx = tid + 512 * i, e = idx >> 4, ch = idx & 15; sv[i] = *(const u32x4*)(sp + e * 128 + ch * 8); }
    float f31[8];
    {
        const int ch = tid & 15;
#pragma unroll
        for (int j = 0; j < 8; ++j) f31[j] = __expf(cum[31 * 128 + ch * 8 + j]);
    }
#pragma unroll
    for (int i = 0; i < 2; ++i) {
        const int idx = tid + 512 * i, c = idx >> 4, ch = idx & 15;
        const float qv[8] = {bflo(rq[i][0]), bfhi(rq[i][0]), bflo(rq[i][1]), bfhi(rq[i][1]), bflo(rq[i][2]), bfhi(rq[i][2]), bflo(rq[i][3]), bfhi(rq[i][3])};
        const float kv[8] = {bflo(rk[i][0]), bfhi(rk[i][0]), bflo(rk[i][1]), bfhi(rk[i][1]), bflo(rk[i][2]), bfhi(rk[i][2]), bflo(rk[i][3]), bfhi(rk[i][3])};
        float qo[8], ko[8];
#pragma unroll
        for (int e = 0; e < 8; ++e) {
            const int d = ch * 8 + e;
            const float df = cum[c * 128 + d] - cum[31 * 128 + d];
            qo[e] = qv[e] * 0.08838834764831845f * __expf(df); ko[e] = kv[e] * __expf(-df);
        }
        u32x4 oq = {pk2(qo[0], qo[1]), pk2(qo[2], qo[3]), pk2(qo[4], qo[5]), pk2(qo[6], qo[7])};
        u32x4 ok = {pk2(ko[0], ko[1]), pk2(ko[2], ko[3]), pk2(ko[4], ko[5]), pk2(ko[6], ko[7])};
        *(u32x4*)(Qp + c * 136 + ch * 8) = oq; *(u32x4*)(Kp + c * 136 + ch * 8) = ok;
    }
    __syncthreads();
#pragma unroll
    for (int i = 0; i < 8; ++i) {
        const int idx = tid + 512 * i, e = idx >> 4, ch = idx & 15;
        u32x4 o = {pk2(bflo(sv[i][0]) * f31[0], bfhi(sv[i][0]) * f31[1]), pk2(bflo(sv[i][1]) * f31[2], bfhi(sv[i][1]) * f31[3]),
                   pk2(bflo(sv[i][2]) * f31[4], bfhi(sv[i][2]) * f31[5]), pk2(bflo(sv[i][3]) * f31[6], bfhi(sv[i][3]) * f31[7])};
        *(u32x4*)(ST + e * 136 + ch * 8) = o;
    }
    __syncthreads();
    const int ib = w & 3, eh = w >> 2, iq = 16 * ib + fr;
    bf16x8 qf[4];
#pragma unroll
    for (int ks = 0; ks < 4; ++ks) qf[ks] = *(const bf16x8*)(Qp + iq * 136 + 32 * ks + 8 * fq);
    float wgt[4][4];
#pragma unroll
    for (int jb = 0; jb < 4; ++jb) {
        f32x4 s = {0.f, 0.f, 0.f, 0.f};
        if (jb <= ib) {
#pragma unroll
            for (int ks = 0; ks < 4; ++ks) s = mfma16(*(const bf16x8*)(Kp + (16 * jb + fr) * 136 + 32 * ks + 8 * fq), qf[ks], s);
        }
#pragma unroll
        for (int q = 0; q < 4; ++q) wgt[jb][q] = (16 * jb + 4 * fq + q <= iq) ? s[q] : 0.f;
    }
    bf16x8 pf[2];
#pragma unroll
    for (int kb = 0; kb < 2; ++kb) pf[kb] = mk8(pk2(wgt[2 * kb][0], wgt[2 * kb][1]), pk2(wgt[2 * kb][2], wgt[2 * kb][3]), pk2(wgt[2 * kb + 1][0], wgt[2 * kb + 1][1]), pk2(wgt[2 * kb + 1][2], wgt[2 * kb + 1][3]));
    f32x4 o[8]; float sq = 0.f;
#pragma unroll
    for (int ebl = 0; ebl < 8; ++ebl) {
        const int eb = 8 * eh + ebl;
        f32x4 a = {0.f, 0.f, 0.f, 0.f};
#pragma unroll
        for (int ks = 0; ks < 4; ++ks) a = mfma16(*(const bf16x8*)(ST + (16 * eb + fr) * 136 + 32 * ks + 8 * fq), qf[ks], a);
#pragma unroll
        for (int kb = 0; kb < 2; ++kb) {
            const bf16_t* vp = VT + (16 * eb + fr) * 72 + 32 * kb + 4 * fq;
            const u32x2 lo = *(const u32x2*)vp, hi = *(const u32x2*)(vp + 16);
            a = mfma16(mk8(lo[0], lo[1], hi[0], hi[1]), pf[kb], a);
        }
        o[ebl] = a; sq += a[0] * a[0] + a[1] * a[1] + a[2] * a[2] + a[3] * a[3];
    }
    sq += shx(sq, 16, lane); sq += shx(sq, 32, lane);
    if (fq == 0) ssq[eh * 64 + iq] = sq;
    __syncthreads();
    const float rinv = rsqrtf((ssq[iq] + ssq[64 + iq]) * (1.f / 256.f) + EPS);
    const size_t trow = (size_t)(t0 + iq);
#pragma unroll
    for (int ebl = 0; ebl < 8; ++ebl) {
        const int e = 16 * (8 * eh + ebl) + 4 * fq;
        const u32x2 rr = *(const u32x2*)(P + pidx((int)trow, C_RG + h * 256 + e));
        const f32x4 gn = *(const f32x4*)(ogain + e);
        const float y0 = o[ebl][0] * rinv * gn[0] * siluf_(bflo(rr[0])), y1 = o[ebl][1] * rinv * gn[1] * siluf_(bfhi(rr[0]));
        const float y2 = o[ebl][2] * rinv * gn[2] * siluf_(bflo(rr[1])), y3 = o[ebl][3] * rinv * gn[3] * siluf_(bfhi(rr[1]));
        u32x2 ov = {pk2(y0, y1), pk2(y2, y3)};
        *(u32x2*)(OG + trow * D + h * 256 + e) = ov;
    }
}

__device__ __forceinline__ void dilmix_phase(const Params& p) {
    const float* ODG = (const float*)(p.ws + W_ODG); const float* LSE = (const float*)(p.ws + W_LSE);
    bf16_t* OD = (bf16_t*)(p.ws + W_OCAT) + 768;
    const int total = gridDim.x * 512;
    for (int idx = bidx() * 512 + tidx(); idx < T * 64; idx += total) {
        const int t = idx >> 6, c4 = idx & 63, hh = c4 >> 5;
        const float l0 = LSE[(size_t)(0 + hh) * T + t], l1 = LSE[(size_t)(2 + hh) * T + t], l2 = LSE[(size_t)(4 + hh) * T + t];
        const float m = fmaxf(l0, fmaxf(l1, l2));
        const float e0 = __expf(l0 - m), e1 = __expf(l1 - m), e2 = __expf(l2 - m), inv = 1.f / (e0 + e1 + e2);
        const f32x4 a0 = *(const f32x4*)(ODG + ((size_t)0 * T + t) * 256 + c4 * 4), a1 = *(const f32x4*)(ODG + ((size_t)1 * T + t) * 256 + c4 * 4), a2 = *(const f32x4*)(ODG + ((size_t)2 * T + t) * 256 + c4 * 4);
        const f32x4 y = (a0 * e0 + a1 * e1 + a2 * e2) * inv;
        u32x2 o = {pk2(y[0], y[1]), pk2(y[2], y[3])};
        *(u32x2*)(OD + (size_t)t * D + c4 * 4) = o;
    }
}

#define XB_TMO      128
#define XB_XCNT(j)  (256  + 64 * (j))
#define XB_XSUB(j)  (1280 + 64 * (j))
#define XB_XGEN(j)  (2304 + 64 * (j))
#define XB_TOP      3328
#define XB_TOPGEN   3392
#define XCD_BAR_WORDS 3456
#define XB_SPIN_CAP (1u << 18)
__device__ __forceinline__ unsigned xb_xcc_id() { return (unsigned)__builtin_amdgcn_s_getreg((3 << 11) | 20) & 0xFu; }
#define XB_SPIN(cond, bar) do { unsigned _sp = 0; while (cond) { __builtin_amdgcn_s_sleep(1); \
    if ((++_sp & 255u) == 0u) { if (xb_ld(&(bar)[XB_TMO])) break; if (_sp > XB_SPIN_CAP) { atomicAdd(&(bar)[XB_TMO], 1u); break; } } } } while (0)
struct XcdBarrier { unsigned* bar; unsigned x; volatile LAS unsigned* st; };
__device__ __forceinline__ XcdBarrier xcd_barrier_post(unsigned* bar, volatile LAS unsigned* st) {
    XcdBarrier b; b.bar = bar; b.x = xb_xcc_id(); b.st = st;
    if (threadIdx.x == 0) st[3] = xb_add(&bar[XB_XCNT(b.x)], 1u);
    return b;
}
__device__ __forceinline__ void xcd_barrier_complete(unsigned* bar, unsigned x, unsigned& nloc, unsigned& nx) {
    const unsigned G = gridDim.x * gridDim.y * gridDim.z;
    unsigned sum, cnt, mine, sp = 0u;
    for (;;) {
        sum = 0u; cnt = 0u; mine = 0u;
#pragma unroll
        for (unsigned j = 0; j < 16; ++j) { const unsigned c = xb_ld(&bar[XB_XCNT(j)]); sum += c; cnt += (c > 0u) ? 1u : 0u; mine = (j == x) ? c : mine; }
        if (sum == G) break;
        __builtin_amdgcn_s_sleep(1);
        if ((++sp & 255u) == 0u) { if (xb_ld(&bar[XB_TMO])) break; if (sp > XB_SPIN_CAP) { atomicAdd(&bar[XB_TMO], 1u); break; } }
    }
    nloc = mine > 0u ? mine : 1u; nx = cnt > 0u ? cnt : 1u;
}
__device__ __forceinline__ void xcd_barrier(const XcdBarrier& b) {
    asm volatile("s_waitcnt vmcnt(0)" ::: "memory");
    __syncthreads();
    if (threadIdx.x == 0) {
        unsigned* bar = b.bar; asm volatile("" : "+s"(bar));
        __builtin_amdgcn_s_waitcnt(0);
        unsigned nloc = b.st[0], nx = b.st[1];
        if (nloc == 0u) { xcd_barrier_complete(bar, b.x, nloc, nx); b.st[0] = nloc; b.st[1] = nx; }
        const unsigned old = xb_add(&bar[XB_XSUB(b.x)], 1u);
        const unsigned gen = old / nloc;
        if (old + 1u == (gen + 1u) * nloc) {
            __builtin_amdgcn_fence(__ATOMIC_RELEASE, "agent");
            asm volatile("s_waitcnt vmcnt(0)" ::: "memory");
            const unsigned og = xb_add(&bar[XB_TOP], 1u);
            const unsigned tg = og / nx;
            if (og + 1u == (tg + 1u) * nx) xb_add(&bar[XB_TOPGEN], 1u);
            else XB_SPIN(xb_ld(&bar[XB_TOPGEN]) == tg, bar);
            __builtin_amdgcn_fence(__ATOMIC_ACQUIRE, "agent");
            asm volatile("s_waitcnt vmcnt(0)" ::: "memory");
        } else {
            XB_SPIN(xb_ld(&bar[XB_TOPGEN]) == gen, bar);
            __builtin_amdgcn_fence(__ATOMIC_ACQUIRE, "agent");
            asm volatile("s_waitcnt vmcnt(0)" ::: "memory");
        }
    }
    __syncthreads();
}

constexpr int PH_PER_LAYER = 10, N_PHASES = 1 + 2 * PH_PER_LAYER;

__device__ __forceinline__ void gemm_job(const Params& p, int l, int gi, unsigned char* lds) {
    unsigned char* wl = p.ws + (size_t)l * SZ_WL;
    pg8::Gemm g; EpiAny E{0, false, l, p, false};
    const bool canfuse = gridDim.x == 256;
    g.M = T; g.N = D; g.K = D; g.A = (const bf16_t*)(p.ws + W_H); g.Bt = (const bf16_t*)wl;
    if (gi == 0) { g.N = NINP; g.Bt = (const bf16_t*)(wl + O_WIN); E.mode = 0; E.PERM = true; }
    else if (gi == 1) { g.A = (const bf16_t*)(p.ws + W_OCAT); g.Bt = (const bf16_t*)(wl + O_WBR); E.mode = 1; E.PERM = true; }
    else if (gi == 2) { g.A = (const bf16_t*)(p.ws + W_YB); g.Bt = (const bf16_t*)(wl + O_WOUT); E.mode = 4; E.PERM = true; E.fuse = canfuse; }
    else if (gi == 3) { g.N = 2 * DFF; g.Bt = (const bf16_t*)(wl + O_WFI); E.mode = 5; E.PERM = true; }
    else { g.K = DFF; g.A = (const bf16_t*)(p.ws + W_PROJ); g.Bt = (const bf16_t*)(wl + O_WFO); E.mode = 6; E.PERM = true; E.fuse = canfuse && l == 0; }
    pg8::StaticOrder S; S.init(g.M, g.N, gridDim.x, (int)*(volatile LAS unsigned*)(LAS unsigned char*)(lds + LDS_BYTES - 8));
    pg8::gemm_phase((LAS unsigned char*)lds, g, S, E);
    const int c = S.c;
    if (gridDim.x == 256) {
        if (gi == 0 && c >= 224) { if (l == 0) conv_phase(p, lds, CV_PER_LAYER, CV_DEF_A, 0, 0, c - 224, 32); else conv_phase(p, lds, CV_PER_LAYER + CV_DEF_C, CV_DEF_D - CV_DEF_C, 0, 0, c - 224, 32); }
        if (gi == 3 && c >= 128) { if (l == 0) conv_phase(p, lds, CV_PER_LAYER + CV_DEF_A, CV_DEF_B - CV_DEF_A, 0, 0, c - 128, 128); else conv_phase(p, lds, CV_PER_LAYER + CV_DEF_D, CV_PER_LAYER - CV_DEF_D, 0, 0, c - 128, 128); }
    } else if (bidx() == 0 && (gi == 0 || gi == 3)) {
        if (gi == 0) { if (l == 0) conv_phase(p, lds, CV_PER_LAYER, CV_DEF_A, 0, 0, 0, 1); else conv_phase(p, lds, CV_PER_LAYER + CV_DEF_C, CV_DEF_D - CV_DEF_C, 0, 0, 0, 1); }
        else { if (l == 0) conv_phase(p, lds, CV_PER_LAYER + CV_DEF_A, CV_DEF_B - CV_DEF_A, 0, 0, 0, 1); else conv_phase(p, lds, CV_PER_LAYER + CV_DEF_D, CV_PER_LAYER - CV_DEF_D, 0, 0, 0, 1); }
    }
}

__device__ __forceinline__ void run_phase(const Params& p0, int ph, unsigned char* lds) {
    Params p = p0; asm volatile("" : "+s"(p.ws));
    const int G = gridDim.x, bid = bidx();
    if (ph == 0) {
        for (int it = bid; it < 256; it += G) mod_item(p, it, lds);
        conv_phase(p, lds, 0, CV_PER_LAYER, CV_PER_LAYER + CV_DEF_B, CV_DEF_C - CV_DEF_B, bid, G);
        return;
    }
    const int l = (ph - 1) / PH_PER_LAYER, q = (ph - 1) % PH_PER_LAYER;
    const float* MOD = (const float*)(p.ws + W_MOD) + l * 12288;
    float* X = (float*)(p.ws + W_X);
    const float* xin = l == 0 ? p.in[0] : X;
    bf16_t* H = (bf16_t*)(p.ws + W_H);
    int g0 = 0, g1 = -1;
    switch (q) {
    case 0: norm_phase(xin, p.in[4] + l * D, MOD, MOD + 2048, H); break;
    case 1: g0 = 0; g1 = 0; break;
    case 2:
        {
            const int nk = (1280 - bid + G - 1) / G;
            for (int k = 0; k < nk; ++k) {
                const int it = bid + ((bid & 1) ? (nk - 1 - k) : k) * G;
                if (it < 384) sb_item(p, it, l, lds); else if (it < 768) dil_item(p, it - 384, l, lds); else gla1_item(p, it - 768, l, lds);
            }
        }
        break;
    case 3: gla2_phase(p); break;
    case 4:
        for (int it = bid; it < 512; it += G) gla3_item(p, it, l, lds);
        dilmix_phase(p);
        break;
    case 5: g0 = 1; g1 = 1; break;
    case 6: g0 = 2; g1 = 2; break;
    case 7: norm_phase(X, p.in[5] + l * D, MOD + 6144, MOD + 8192, H); break;
    case 8: g0 = 3; g1 = 3; break;
    case 9: g0 = 4; g1 = 4; break;
    }
#pragma unroll 1
    for (int gi = g0; gi <= g1; ++gi) { __syncthreads(); gemm_job(p, l, gi, lds); }
}

__global__ void __launch_bounds__(512, 2) fwd_megakernel(Params p) {
    extern __shared__ __attribute__((aligned(16))) unsigned char lds[];
    cg::grid_group grid = cg::this_grid();
    volatile LAS unsigned* st = (volatile LAS unsigned*)(LAS unsigned char*)(lds + LDS_BYTES - 16);
    if (threadIdx.x == 0) { st[0] = 0u; st[1] = 0u; st[2] = blockIdx.x; }
    __syncthreads();
    const XcdBarrier xb = xcd_barrier_post((unsigned*)(p.ws + W_BAR), st);
    if (p.ph_lo < 0) grid.sync();
#define GSYNC(ph) xcd_barrier(xb)
    for (int ph = p.ph_lo; ph < p.ph_hi; ++ph) {
        if (gridDim.x == 256 && ph >= 1) {
            const int l = (ph - 1) / PH_PER_LAYER, q = (ph - 1) % PH_PER_LAYER;
            if (q == 7 || (q == 0 && l == 1)) continue;
        }
        run_phase(p, ph, lds);
        if (ph + 1 < p.ph_hi) GSYNC(ph);
        if (ph == 0) {
            if (threadIdx.x == 0) {
                unsigned* bar = (unsigned*)(p.ws + W_BAR); bool ok = (gridDim.x & 7u) == 0u;
                for (unsigned j = 0; j < 16; ++j) { const unsigned c = xb_ld(&bar[XB_XCNT(j)]); ok = ok && (c == (j < 8 ? gridDim.x / 8u : 0u)); }
                if (ok) st[2] = st[3] * 8u + xb.x;
            }
            __syncthreads();
        }
    }
}

extern "C" void kernel_launch(void* const* d_in, const int* in_sizes, int n_in, void* d_out, int out_size, void* d_ws, size_t ws_size, hipStream_t stream) {
    static int grid_blocks = 0;
    if (!grid_blocks) {
        int dev = 0, cus = 0, per_cu = 0;
        hipGetDevice(&dev);
        hipDeviceGetAttribute(&cus, hipDeviceAttributeMultiprocessorCount, dev);
        hipFuncSetAttribute((const void*)fwd_megakernel, hipFuncAttributeMaxDynamicSharedMemorySize, LDS_BYTES);
        hipOccupancyMaxActiveBlocksPerMultiprocessor(&per_cu, (const void*)fwd_megakernel, 512, LDS_BYTES);
        if (per_cu < 1) { fprintf(stderr, "kernel_launch: occupancy query says %d blocks per CU\n", per_cu); per_cu = 1; }
        (void)hipGetLastError();
        grid_blocks = cus * per_cu;
        if (ws_size < W_END) { fprintf(stderr, "kernel_launch: workspace too small: %zu < %zu; nothing launched\n", ws_size, (size_t)W_END); grid_blocks = -1; }
    }
    if (grid_blocks < 0) return;
    Params p{};
    for (int i = 0; i < 20; ++i) p.in[i] = (const float*)d_in[i];
    p.out = (float*)d_out; p.ws = (unsigned char*)d_ws; p.ph_lo = 0; p.ph_hi = N_PHASES;
    (void)hipMemsetAsync((unsigned char*)d_ws + W_BAR, 0, 16384 + 3 * 32 * 256, stream);
    void* args[] = {&p};
    hipError_t e = hipLaunchCooperativeKernel((const void*)fwd_megakernel, dim3(grid_blocks), dim3(512), args, LDS_BYTES, stream);
    if (e != hipSuccess) fprintf(stderr, "cooperative launch failed: %s (grid %d)\n", hipGetErrorString(e), grid_blocks);
}
```

```cpp
#include <hip/hip_runtime.h>
#include <hip/hip_cooperative_groups.h>
#include <cstdio>
namespace cg = cooperative_groups;

#define LAS __attribute__((address_space(3)))
typedef unsigned short bf16_t;
typedef short bf16x8 __attribute__((ext_vector_type(8)));
typedef float f32x4 __attribute__((ext_vector_type(4)));
typedef unsigned u32x4 __attribute__((ext_vector_type(4)));
typedef unsigned u32x2 __attribute__((ext_vector_type(2)));

constexpr int T = 8192, D = 2048, NIN = 13840, NINP = 14080, DFF = 5632;
constexpr int C_QSB = 0, C_KSB = 768, C_VSB = 1536, C_QDIL = 2304, C_KDIL = 3072, C_VDIL = 3840, C_QG = 4608, C_KG = 5120, C_VG = 5632, C_RG = 6656, C_GATE = 7696;
constexpr float EPS = 1e-6f;
constexpr int LDS_BYTES = 143360;

constexpr size_t SZ_WIN = (size_t)NINP * D * 2, SZ_WBS = (size_t)D * 768 * 2, SZ_WBD = (size_t)D * 256 * 2, SZ_WBG = (size_t)D * 1024 * 2,
                 SZ_WOUT = (size_t)D * D * 2, SZ_WFI = (size_t)2 * DFF * D * 2, SZ_WFO = (size_t)D * DFF * 2;
constexpr size_t O_WIN = 0, O_WBR = O_WIN + SZ_WIN  , O_WOUT = O_WBR + SZ_WBS + SZ_WBD + SZ_WBG, O_WFI = O_WOUT + SZ_WOUT,
                 O_WFO = O_WFI + SZ_WFI, SZ_WL = O_WFO + SZ_WFO;
constexpr size_t W_MOD = 2 * SZ_WL;
constexpr size_t W_X = W_MOD + 2 * 12288 * 4;
constexpr size_t W_H = W_X + (size_t)T * D * 4;
constexpr size_t W_PROJ = W_H + (size_t)T * D * 2;
constexpr size_t W_AGLA = W_PROJ + (size_t)T * NINP * 2;
constexpr size_t W_ODG = W_AGLA + (size_t)T * 16 * 4;
constexpr size_t W_LSE = W_ODG + (size_t)3 * T * 256 * 4;
constexpr size_t W_DL = W_LSE + (size_t)3 * 2 * T * 4;
constexpr size_t W_U = W_DL + (size_t)4 * 128 * 128 * 4;
constexpr size_t W_SP = W_U + (size_t)4 * 128 * 32768 * 2;
constexpr size_t W_CUM = W_SP + (size_t)4 * 128 * 32768 * 2;
constexpr size_t W_OCAT = W_CUM + (size_t)T * 512 * 4;
constexpr size_t W_YB = W_OCAT + (size_t)T * D * 2;
constexpr size_t W_BAR = W_YB + (size_t)T * D * 2;
constexpr size_t W_FCNT = W_BAR + 16384;
constexpr size_t W_FSLOT = W_BAR + 65536;
constexpr size_t W_END = W_FSLOT + (size_t)3 * 32 * 256 * 8 * 4;

struct Params {
    const float* in[20];
    float* out;
    unsigned char* ws;
    int ph_lo, ph_hi;
};

typedef __bf16 bf16v2_t __attribute__((ext_vector_type(2)));
typedef float f32v2_t __attribute__((ext_vector_type(2)));
__device__ __forceinline__ unsigned pk2(float lo, float hi) { const f32v2_t v = {lo, hi}; return __builtin_bit_cast(unsigned, __builtin_convertvector(v, bf16v2_t)); }
__device__ __forceinline__ int tidx() { int t = threadIdx.x; asm volatile("" : "+v"(t)); return t; }
__device__ __forceinline__ int bidx() { int b = blockIdx.x; asm volatile("" : "+s"(b)); return b; }
__device__ __forceinline__ float shx(float v, int mask, int lane) { return __int_as_float(__builtin_amdgcn_ds_bpermute((lane ^ mask) << 2, __float_as_int(v))); }
__device__ __forceinline__ unsigned xb_ld(unsigned* p)              { return __hip_atomic_load(p, __ATOMIC_RELAXED, __HIP_MEMORY_SCOPE_AGENT); }
__device__ __forceinline__ unsigned xb_add(unsigned* p, unsigned v) { return __hip_atomic_fetch_add(p, v, __ATOMIC_RELAXED, __HIP_MEMORY_SCOPE_AGENT); }
__device__ __forceinline__ size_t pidx(int row, int col) { return (size_t)(col >> 7) * ((size_t)T * 128) + (size_t)row * 128 + (col & 127); }
__device__ __forceinline__ float bflo(unsigned u) { return __uint_as_float(u << 16); }
__device__ __forceinline__ float bfhi(unsigned u) { return __uint_as_float(u & 0xffff0000u); }
__device__ __forceinline__ float bf1(bf16_t b) { return __uint_as_float(((unsigned)b) << 16); }
__device__ __forceinline__ float sigmoidf_(float x) { return 1.f / (1.f + __expf(-x)); }
__device__ __forceinline__ float sigc(float x) { return __builtin_amdgcn_rcpf(1.f + __expf(-fminf(fmaxf(x, -30.f), 30.f))); }
__device__ __forceinline__ float sigratio(float a, float b) { return (1.f + __expf(-fminf(fmaxf(b, -30.f), 30.f))) * __builtin_amdgcn_rcpf(1.f + __expf(-fminf(fmaxf(a, -30.f), 30.f))); }
__device__ __forceinline__ float siluf_(float x) { return x * __builtin_amdgcn_rcpf(1.f + __expf(-fmaxf(x, -80.f))); }
__device__ __forceinline__ f32x4 mfma16(bf16x8 a, bf16x8 b, f32x4 c) { return __builtin_amdgcn_mfma_f32_16x16x32_bf16(a, b, c, 0, 0, 0); }
__device__ __forceinline__ bf16x8 mk8(unsigned a, unsigned b, unsigned c, unsigned d) { u32x4 v = {a, b, c, d}; return __builtin_bit_cast(bf16x8, v); }

namespace pg8 {
constexpr int BM = 256, BK = 64, HALF = 128, HTB = HALF * BK * 2, STAGE_BYTES = 8 * HTB, NXCD = 8, WGM = 8;
__host__ __device__ __forceinline__ int lds_byte(int r, int c) { const int st = (r >> 4) * 2 + (c >> 5), rr = r & 15, cc = c & 31, ob = rr * 64 + cc * 2; return st * 1024 + (ob ^ (((ob >> 9) & 1) << 5)); }
__host__ __device__ __forceinline__ void stage_rc(int b, int& R, int& C) { const int st = b / 1024, sb = b % 1024, swz = sb ^ (((sb >> 9) & 1) << 5); R = (st >> 1) * 16 + swz / 64; C = (st & 1) * 32 + (swz % 64) / 2; }
__host__ __device__ __forceinline__ int perm32(int rho) { const int n = rho >> 4, i = rho & 15; return 8 * (i >> 2) + 4 * n + (i & 3); }
struct Unit { int pm, pn; };
struct Gemm { const bf16_t* A; const bf16_t* Bt; int M, N, K; };
struct StaticOrder {
    int nM, nN, nwg, G, c;
    __host__ __device__ void init(int M, int N, int G_, int c_) { nM = M / BM; nN = N / BM; nwg = nM * nN; G = G_; c = c_; }
    __host__ __device__ bool next(int i, Unit& u) const {
        const long L = (long)i * G + c; if (L >= nwg) return false;
        int wgid = (int)L; { const int q = nwg / NXCD, r = nwg % NXCD, xcd = wgid % NXCD, off = wgid / NXCD; wgid = (xcd < r ? xcd * (q + 1) : r * (q + 1) + (xcd - r) * q) + off; }
        const int nig = WGM * nN, gid = wgid / nig, fm = gid * WGM, gsz = (nM - fm) < WGM ? (nM - fm) : WGM;
        u.pm = fm + ((wgid % nig) % gsz); u.pn = (wgid % nig) / gsz; return true;
    }
};

template <class Epi>
__device__ __forceinline__ void gemm_phase(LAS unsigned char* lds, const Gemm g, const StaticOrder& S, const Epi& E) {
    const int tid = tidx(), wid = __builtin_amdgcn_readfirstlane(tid >> 6), lane = tid & 63, wr = wid >> 2, wc = wid & 3, fr = lane & 15, fq = lane >> 4;
    const int K = g.K, nt = K / BK;
    unsigned voffA[2], voffB[2];
#pragma unroll
    for (int i = 0; i < 2; ++i) { int R, C; stage_rc(tid * 16 + i * 8192, R, C); const int Rb = E.PERM ? ((R & ~31) + perm32(R & 31)) : R;
        voffA[i] = (unsigned)(R * K + C) * 2u; voffB[i] = (unsigned)(Rb * K + C) * 2u; }
    const size_t kstep = (size_t)(BK * 2);
    const size_t hstep = (size_t)HALF * K * 2;
    const size_t tstep = 2 * hstep;
    const unsigned ldsw = (unsigned)wid * 1024u;
    const int aoff = lds_byte(wr * 64 + fr, fq * 8), boff = lds_byte(wc * 32 + fr, fq * 8);
#define PG8_SA(b, h) (((b) * 2 + (h)) * HTB)
#define PG8_SB(b, h) ((4 + (b) * 2 + (h)) * HTB)
#define PG8_STAGE(bufoff, gbase, voff) do { _Pragma("unroll") for (int _i = 0; _i < 2; ++_i) \
        __builtin_amdgcn_global_load_lds((const unsigned*)((const char*)(gbase) + (voff)[_i]), (LAS unsigned*)(lds + (bufoff) + ldsw + _i * 8192), 16, 0, 0); } while (0)
#define PG8_LDA(dst, b, h) do { _Pragma("unroll") for (int m = 0; m < 4; ++m) _Pragma("unroll") for (int k = 0; k < 2; ++k) dst[m][k] = *(const LAS bf16x8*)(lds + PG8_SA(b, h) + aoff + m * 2048 + k * 1024); } while (0)
#define PG8_LDB(dst, b, h) do { _Pragma("unroll") for (int n = 0; n < 2; ++n) _Pragma("unroll") for (int k = 0; k < 2; ++k) dst[n][k] = *(const LAS bf16x8*)(lds + PG8_SB(b, h) + boff + n * 2048 + k * 1024); } while (0)
#define PG8_MMA(ai, bj, At, Bt) do { __builtin_amdgcn_s_setprio(1); _Pragma("unroll") for (int m = 0; m < 4; ++m) _Pragma("unroll") for (int n = 0; n < 2; ++n) _Pragma("unroll") for (int k = 0; k < 2; ++k) \
        acc[ai][bj][m][n] = __builtin_amdgcn_mfma_f32_16x16x32_bf16(Bt[n][k], At[m][k], acc[ai][bj][m][n], 0, 0, 0); __builtin_amdgcn_s_setprio(0); } while (0)
#define PG8_WAIT_V(n) asm volatile("s_waitcnt vmcnt(" #n ")" ::: "memory")
#define PG8_WAIT_L(n) asm volatile("s_waitcnt lgkmcnt(" #n ")" ::: "memory")
#define PG8_BAR __builtin_amdgcn_s_barrier()
#define PG8_SCHED __builtin_amdgcn_sched_barrier(0)
    Unit cur, nxt; int ui = 0;
    if (!S.next(0, cur)) return;
    f32x4 acc[2][2][4][2];
#pragma unroll
    for (int a = 0; a < 2; ++a)
#pragma unroll
        for (int b = 0; b < 2; ++b)
#pragma unroll
            for (int m = 0; m < 4; ++m)
#pragma unroll
                for (int n = 0; n < 2; ++n) acc[a][b][m][n] = (f32x4){0.f, 0.f, 0.f, 0.f};
    bf16x8 At[4][2], B0[2][2], B1[2][2];
    const char* cA = (const char*)g.A + (size_t)cur.pm * tstep; const char* cB = (const char*)g.Bt + (size_t)cur.pn * tstep;
    PG8_STAGE(PG8_SB(0, 0), cB, voffB); PG8_STAGE(PG8_SA(0, 0), cA, voffA); PG8_STAGE(PG8_SB(0, 1), cB + hstep, voffB); PG8_STAGE(PG8_SA(0, 1), cA + hstep, voffA);
    if (wr == 1) PG8_BAR;
    PG8_WAIT_V(4); PG8_BAR;
    PG8_STAGE(PG8_SB(1, 0), cB + kstep, voffB); PG8_STAGE(PG8_SA(1, 0), cA + kstep, voffA); PG8_STAGE(PG8_SB(1, 1), cB + hstep + kstep, voffB);
    PG8_WAIT_V(6); PG8_BAR;
    for (;;) {
        const bool has_next = S.next(ui + 1, nxt);
        const char* nA = has_next ? (const char*)g.A + (size_t)nxt.pm * tstep : cA; const char* nB = has_next ? (const char*)g.Bt + (size_t)nxt.pn * tstep : cB;
        int t = 0;
#pragma unroll 1
        for (int seg = 0; seg < 3; ++seg) {
        const int tend = (E.mode == 1) ? (seg == 0 ? 12 : (seg == 1 ? 16 : nt)) : (seg == 0 ? nt : 0);
#pragma unroll 1
        for (; t < tend; t += 2) {
            const bool last = (t == nt - 2);
            const char* a1 = cA + (size_t)(t + 1) * kstep;
            const char* a2 = last ? nA : cA + (size_t)(t + 2) * kstep; const char* b2 = last ? nB : cB + (size_t)(t + 2) * kstep;
            const char* a3 = a2 + kstep; const char* b3 = b2 + kstep;
            PG8_LDB(B0, 0, 0); PG8_SCHED; PG8_LDA(At, 0, 0); PG8_STAGE(PG8_SA(1, 1), a1 + hstep, voffA);
            PG8_WAIT_L(8); PG8_BAR; PG8_WAIT_L(0); PG8_MMA(0, 0, At, B0); PG8_BAR; PG8_SCHED;
            PG8_LDB(B1, 0, 1); PG8_STAGE(PG8_SB(0, 0), b2, voffB);
            PG8_BAR; PG8_WAIT_L(0); PG8_MMA(0, 1, At, B1); PG8_BAR;
            PG8_LDA(At, 0, 1); PG8_STAGE(PG8_SA(0, 0), a2, voffA);
            PG8_BAR; PG8_WAIT_L(0); PG8_MMA(1, 0, At, B0); PG8_BAR; PG8_SCHED;
            PG8_STAGE(PG8_SB(0, 1), b2 + hstep, voffB);
            PG8_WAIT_V(6); PG8_BAR; PG8_MMA(1, 1, At, B1); PG8_BAR;
            PG8_LDB(B0, 1, 0); PG8_SCHED; PG8_LDA(At, 1, 0); PG8_STAGE(PG8_SA(0, 1), a2 + hstep, voffA);
            PG8_WAIT_L(8); PG8_BAR; PG8_WAIT_L(0); PG8_MMA(0, 0, At, B0); PG8_BAR; PG8_SCHED;
            PG8_LDB(B1, 1, 1); PG8_STAGE(PG8_SB(1, 0), b3, voffB);
            PG8_BAR; PG8_WAIT_L(0); PG8_MMA(0, 1, At, B1); PG8_BAR;
            PG8_LDA(At, 1, 1); PG8_STAGE(PG8_SA(1, 0), a3, voffA);
            PG8_BAR; PG8_WAIT_L(0); PG8_MMA(1, 0, At, B0); PG8_BAR; PG8_SCHED;
            PG8_STAGE(PG8_SB(1, 1), b3 + hstep, voffB);
            PG8_WAIT_V(6); PG8_BAR; PG8_MMA(1, 1, At, B1); PG8_BAR;
        }
        if (E.mode == 1 && seg < 2) E.hook(acc, cur, wr, wc, fr, fq, seg);
        }
        if (!E.fuse) E(acc, cur, wr, wc, fr, fq);
        if (!has_next) break;
#pragma unroll
        for (int a = 0; a < 2; ++a)
#pragma unroll
            for (int b = 0; b < 2; ++b)
#pragma unroll
                for (int m = 0; m < 4; ++m)
#pragma unroll
                    for (int n = 0; n < 2; ++n) acc[a][b][m][n] = (f32x4){0.f, 0.f, 0.f, 0.f};
        cur = nxt; cA = nA; cB = nB; ++ui;
    }
    PG8_WAIT_V(0);
    if (wr == 0) PG8_BAR;
    PG8_BAR;
    if (E.fuse) E.fused(acc, cur, wr, wc, fr, fq, (unsigned char*)lds);
#undef PG8_SA
#undef PG8_SB
#undef PG8_STAGE
#undef PG8_LDA
#undef PG8_LDB
#undef PG8_MMA
#undef PG8_WAIT_V
#undef PG8_WAIT_L
#undef PG8_BAR
#undef PG8_SCHED
}
}

struct EpiAny {
    int mode; bool PERM;
    int l; const Params& p; bool fuse;
#define EPI_SETUP() int ll = l; asm volatile("" : "+s"(ll)); unsigned char* const ws = p.ws; bf16_t* const P = (bf16_t*)(ws + W_PROJ); (void)P; \
        const float* const MOD = (const float*)(ws + W_MOD) + ll * 12288; (void)MOD; float* const X = (float*)(ws + W_X); (void)X
    __device__ __forceinline__ void hook(f32x4 (&acc)[2][2][4][2], const pg8::Unit& u, int wr, int wc, int fr, int fq, int which) const {
        EPI_SETUP();
        int row0 = u.pm * 256 + wr * 64 + fr; asm volatile("" : "+v"(row0));
        const int col0 = u.pn * 256 + wc * 32 + 8 * fq;
        const int gc0 = C_GATE + which * 2048 + col0;
        u32x4 gb[2][2][2];
#define HOOK_LD(it, bf) do { const int gr = row0 + ((it) >> 2) * 128 + ((it) & 3) * 16; \
        _Pragma("unroll") for (int bj = 0; bj < 2; ++bj) { gb[bf][bj][0] = *(const u32x4*)(P + pidx(gr, gc0 + bj * 128)); gb[bf][bj][1] = *(const u32x4*)(P + pidx(gr, gc0 + 2048 + bj * 128)); } } while (0)
        HOOK_LD(0, 0);
#pragma unroll
        for (int it = 0; it < 8; ++it) {
            if (it < 7) HOOK_LD(it + 1, (it + 1) & 1);
            const int ai = it >> 2, m = it & 3;
#pragma unroll
            for (int bj = 0; bj < 2; ++bj) {
                const u32x4 ga = gb[it & 1][bj][0], gq = gb[it & 1][bj][1];
#pragma unroll
                for (int n = 0; n < 2; ++n) {
                    f32x4 r = {sigratio(bflo(ga[2 * n]), bflo(gq[2 * n])), sigratio(bfhi(ga[2 * n]), bfhi(gq[2 * n])), sigratio(bflo(ga[2 * n + 1]), bflo(gq[2 * n + 1])), sigratio(bfhi(ga[2 * n + 1]), bfhi(gq[2 * n + 1]))};
                    acc[ai][bj][m][n] *= r;
                }
            }
            asm volatile("" ::: "memory");
        }
#undef HOOK_LD
    }
    __device__ __forceinline__ void fused(f32x4 (&acc)[2][2][4][2], const pg8::Unit& u, int wr, int wc, int fr, int fq, unsigned char* lds) const {
        EPI_SETUP();
        const int tid = tidx(), lane = tid & 63;
        int row0 = u.pm * 256 + wr * 64 + fr; asm volatile("" : "+v"(row0));
        const int col0 = u.pn * 256 + wc * 32 + 8 * fq;
        const float* const xin = (mode == 4 && ll == 0) ? p.in[0] : X;
        const float* const gate = MOD + (mode == 4 ? 4096 : 10240);
        const int site = mode == 4 ? ll : 2;
        const float* const ngain = mode == 4 ? p.in[5] + ll * D : p.in[4] + D;
        const float* const nshift = mode == 4 ? MOD + 6144 : MOD + 12288;
        const float* const nscale = mode == 4 ? MOD + 8192 : MOD + 12288 + 2048;
        float* tab = (float*)lds; float* invtab = (float*)(lds + 4096);
        f32x4 gv[2][2], xb[2][2][2];
#pragma unroll
        for (int bj = 0; bj < 2; ++bj)
#pragma unroll
            for (int n = 0; n < 2; ++n) gv[bj][n] = *(const f32x4*)(gate + col0 + bj * 128 + n * 4);
#define F4_LD(it, bf) do { const float* xp = xin + (size_t)(row0 + ((it) >> 2) * 128 + ((it) & 3) * 16) * D + col0; \
        _Pragma("unroll") for (int bj = 0; bj < 2; ++bj) _Pragma("unroll") for (int n = 0; n < 2; ++n) xb[bf][bj][n] = *(const f32x4*)(xp + bj * 128 + n * 4); } while (0)
        F4_LD(0, 0);
#pragma unroll
        for (int it = 0; it < 8; ++it) {
            if (it < 7) F4_LD(it + 1, (it + 1) & 1);
            const int ai = it >> 2, m = it & 3;
            float* op = X + (size_t)(row0 + ai * 128 + m * 16) * D + col0;
            float ps = 0.f;
#pragma unroll
            for (int bj = 0; bj < 2; ++bj)
#pragma unroll
                for (int n = 0; n < 2; ++n) {
                    const f32x4 xv = xb[it & 1][bj][n] + gv[bj][n] * acc[ai][bj][m][n];
                    *(f32x4*)(op + bj * 128 + n * 4) = xv;
                    acc[ai][bj][m][n] = xv;
                    ps += xv[0] * xv[0] + xv[1] * xv[1] + xv[2] * xv[2] + xv[3] * xv[3];
                }
            ps += shx(ps, 16, lane); ps += shx(ps, 32, lane);
            if (fq == 0) tab[(ai * 128 + wr * 64 + m * 16 + fr) * 4 + wc] = ps;
            asm volatile("" ::: "memory");
        }
#undef F4_LD
        __syncthreads();
        unsigned* const cnt = (unsigned*)(ws + W_FCNT) + (site * 32 + u.pm) * 64;
        unsigned* const slot = (unsigned*)(ws + W_FSLOT) + ((size_t)(site * 32 + u.pm) * 256) * 8;
        if (tid < 256) {
            const f32x4 t4 = *(const f32x4*)(tab + tid * 4);
            __hip_atomic_store(slot + tid * 8 + u.pn, __float_as_uint(t4[0] + t4[1] + t4[2] + t4[3]), __ATOMIC_RELAXED, __HIP_MEMORY_SCOPE_AGENT);
        }
        asm volatile("s_waitcnt vmcnt(0)" ::: "memory");
        __syncthreads();
        if (tid == 0) {
            (void)xb_add(cnt, 1u);
            unsigned sp_ = 0;
            while (xb_ld(cnt) < 8u) { __builtin_amdgcn_s_sleep(1); if (++sp_ > (1u << 22)) break; }
        }
        __syncthreads();
        if (tid < 256) {
            float sum = 0.f;
#pragma unroll
            for (int j = 0; j < 8; ++j) sum += __uint_as_float(xb_ld(slot + tid * 8 + j));
            invtab[tid] = rsqrtf(sum * (1.f / D) + EPS);
        }
        __syncthreads();
        bf16_t* const H = (bf16_t*)(ws + W_H);
        f32x4 cmv[2][2], shv[2][2];
#pragma unroll
        for (int bj = 0; bj < 2; ++bj)
#pragma unroll
            for (int n = 0; n < 2; ++n) {
                const int c = col0 + bj * 128 + n * 4;
                cmv[bj][n] = *(const f32x4*)(ngain + c) * (1.f + *(const f32x4*)(nscale + c)); shv[bj][n] = *(const f32x4*)(nshift + c);
            }
#pragma unroll
        for (int it = 0; it < 8; ++it) {
            const int ai = it >> 2, m = it & 3;
            const float inv = invtab[ai * 128 + wr * 64 + m * 16 + fr];
            bf16_t* hp = H + (size_t)(row0 + ai * 128 + m * 16) * D + col0;
#pragma unroll
            for (int bj = 0; bj < 2; ++bj) {
                const f32x4 y0 = acc[ai][bj][m][0] * inv * cmv[bj][0] + shv[bj][0], y1 = acc[ai][bj][m][1] * inv * cmv[bj][1] + shv[bj][1];
                u32x4 o = {pk2(y0[0], y0[1]), pk2(y0[2], y0[3]), pk2(y1[0], y1[1]), pk2(y1[2], y1[3])};
                *(u32x4*)(hp + bj * 128) = o;
            }
        }
    }
    __device__ __forceinline__ void operator()(const f32x4 (&acc)[2][2][4][2], const pg8::Unit& u, int wr, int wc, int fr, int fq) const {
        EPI_SETUP();
        int row0 = u.pm * 256 + wr * 64 + fr; asm volatile("" : "+v"(row0));
        if (mode == 0) {
            float* const agla = (float*)(ws + W_AGLA);
            const int col0 = u.pn * 256 + wc * 32 + 8 * fq;
#pragma unroll
            for (int ai = 0; ai < 2; ++ai)
#pragma unroll
                for (int m = 0; m < 4; ++m) {
                    const int row = row0 + ai * 128 + m * 16;
                    bf16_t* rp = P + pidx(row, col0);
#pragma unroll
                    for (int bj = 0; bj < 2; ++bj) {
                        const f32x4 v0 = acc[ai][bj][m][0], v1 = acc[ai][bj][m][1];
                        u32x4 o = {pk2(v0[0], v0[1]), pk2(v0[2], v0[3]), pk2(v1[0], v1[1]), pk2(v1[2], v1[3])};
                        *(u32x4*)(rp + (size_t)bj * T * 128) = o;
                    }
                    if (u.pn == 30 && wc == 0 && fq < 2) { float* a = agla + (size_t)row * 16 + 8 * fq; *(f32x4*)a = acc[ai][0][m][0]; *(f32x4*)(a + 4) = acc[ai][0][m][1]; }
                }
        } else if (mode == 1) {
            bf16_t* const YB = (bf16_t*)(ws + W_YB);
            const int col0 = u.pn * 256 + wc * 32 + 8 * fq;
            const int gc2 = C_GATE + 4096 + col0;
            u32x4 gb[2][2];
#define M1_LD(it, bf) do { const int gr = row0 + ((it) >> 2) * 128 + ((it) & 3) * 16; \
            _Pragma("unroll") for (int bj = 0; bj < 2; ++bj) gb[bf][bj] = *(const u32x4*)(P + pidx(gr, gc2 + bj * 128)); } while (0)
            M1_LD(0, 0);
#pragma unroll
            for (int it = 0; it < 8; ++it) {
                if (it < 7) M1_LD(it + 1, (it + 1) & 1);
                const int ai = it >> 2, m = it & 3, row = row0 + ai * 128 + m * 16;
#pragma unroll
                for (int bj = 0; bj < 2; ++bj) {
                    const u32x4 gw = gb[it & 1][bj];
                    const f32x4 a0 = acc[ai][bj][m][0], a1 = acc[ai][bj][m][1];
                    u32x4 o = {pk2(sigc(bflo(gw[0])) * a0[0], sigc(bfhi(gw[0])) * a0[1]), pk2(sigc(bflo(gw[1])) * a0[2], sigc(bfhi(gw[1])) * a0[3]),
                               pk2(sigc(bflo(gw[2])) * a1[0], sigc(bfhi(gw[2])) * a1[1]), pk2(sigc(bflo(gw[3])) * a1[2], sigc(bfhi(gw[3])) * a1[3])};
                    *(u32x4*)(YB + (size_t)row * D + col0 + bj * 128) = o;
                }
                asm volatile("" ::: "memory");
            }
#undef M1_LD
        } else if (mode == 4 || mode == 6) {
            const float* const xin = (mode == 4 && ll == 0) ? p.in[0] : X;
            const float* const gate = MOD + (mode == 4 ? 4096 : 10240);
            float* const out = (mode == 6 && ll == 1) ? p.out : X;
            const int col0 = u.pn * 256 + wc * 32 + 8 * fq;
            f32x4 gv[2][2], xb[2][2][2];
#pragma unroll
            for (int bj = 0; bj < 2; ++bj)
#pragma unroll
                for (int n = 0; n < 2; ++n) gv[bj][n] = *(const f32x4*)(gate + col0 + bj * 128 + n * 4);
#define M4_LD(it, bf) do { const float* xp = xin + (size_t)(row0 + ((it) >> 2) * 128 + ((it) & 3) * 16) * D + col0; \
            _Pragma("unroll") for (int bj = 0; bj < 2; ++bj) _Pragma("unroll") for (int n = 0; n < 2; ++n) xb[bf][bj][n] = *(const f32x4*)(xp + bj * 128 + n * 4); } while (0)
            M4_LD(0, 0);
#pragma unroll
            for (int it = 0; it < 8; ++it) {
                if (it < 7) M4_LD(it + 1, (it + 1) & 1);
                const int ai = it >> 2, m = it & 3;
                float* op = out + (size_t)(row0 + ai * 128 + m * 16) * D + col0;
#pragma unroll
                for (int bj = 0; bj < 2; ++bj)
#pragma unroll
                    for (int n = 0; n < 2; ++n) { const f32x4 xo = xb[it & 1][bj][n] + gv[bj][n] * acc[ai][bj][m][n]; if (out == p.out) __builtin_nontemporal_store(xo, (f32x4*)(op + bj * 128 + n * 4)); else *(f32x4*)(op + bj * 128 + n * 4) = xo; }
                asm volatile("" ::: "memory");
            }
#undef M4_LD
        } else {
            const int col0 = u.pn * 128 + wc * 32 + 8 * fq;
#pragma unroll
            for (int ai = 0; ai < 2; ++ai)
#pragma unroll
                for (int m = 0; m < 4; ++m) {
                    const int row = row0 + ai * 128 + m * 16;
                    float h[8];
#pragma unroll
                    for (int n = 0; n < 2; ++n)
#pragma unroll
                        for (int j = 0; j < 4; ++j) h[n * 4 + j] = siluf_(acc[ai][0][m][n][j]) * acc[ai][1][m][n][j];
                    u32x4 o = {pk2(h[0], h[1]), pk2(h[2], h[3]), pk2(h[4], h[5]), pk2(h[6], h[7])};
                    *(u32x4*)(P + (size_t)row * DFF + col0) = o;
                }
        }
    }
};

__device__ __forceinline__ void mod_item(const Params& p, int item, unsigned char* lds) {
    const int tid = tidx();
    float* sc = (float*)lds; float* part = (float*)(lds + 8192);
    const int l = item >> 7, j0 = (item & 127) * 96;
    const float* c = p.in[1]; const float* w = p.in[2] + (size_t)l * D * 12288; const float* b = p.in[3] + l * 12288;
    float* MOD = (float*)(p.ws + W_MOD);
    for (int i = tid; i < D; i += 512) { const float v = c[i]; sc[i] = siluf_(v); }
    __syncthreads();
    const int cgp = tid % 24, ks = tid / 24;
    if (ks < 21) {
        f32x4 a = {0.f, 0.f, 0.f, 0.f};
#pragma unroll 8
        for (int k = ks; k < D; k += 21) { const f32x4 wv = __builtin_nontemporal_load((const f32x4*)(w + (size_t)k * 12288 + j0 + cgp * 4)); a += sc[k] * wv; }
        *(f32x4*)(part + ks * 96 + cgp * 4) = a;
    }
    __syncthreads();
    if (tid < 96) { float s = b[j0 + tid]; for (int q = 0; q < 21; ++q) s += part[q * 96 + tid]; MOD[l * 12288 + j0 + tid] = s; }
    __syncthreads();
}

struct ConvDesc { const float* src; bf16_t* dst; int Nsrc, nvalid, K; };
constexpr int CV_PER_LAYER = 4384;
__device__ __forceinline__ ConvDesc conv_desc(const Params& p, int item) {
    const int l = item / CV_PER_LAYER; int r = item % CV_PER_LAYER;
    unsigned char* wl = p.ws + (size_t)l * SZ_WL;
    ConvDesc d; d.nvalid = 128;
    if (r < 1760) { const int kt = r / 110, nt = r % 110; int nv = NIN - nt * 128; d.nvalid = nv < 0 ? 0 : (nv > 128 ? 128 : nv); d.Nsrc = NIN; d.K = D;
        d.src = p.in[6] + (size_t)l * D * NIN + (size_t)(kt * 128) * NIN + nt * 128; d.dst = (bf16_t*)(wl + O_WIN) + (size_t)(nt * 128) * D + kt * 128; return d; }
    r -= 1760;
    if (r < 96) { const int kt = r >> 4, nt = r & 15; d.Nsrc = D; d.K = D;
        d.src = p.in[14] + (size_t)l * 768 * D + (size_t)(kt * 128) * D + nt * 128; d.dst = (bf16_t*)(wl + O_WBR) + (size_t)(nt * 128) * D + kt * 128; return d; }
    r -= 96;
    if (r < 32) { const int kt = r >> 4, nt = r & 15; d.Nsrc = D; d.K = D;
        d.src = p.in[15] + (size_t)l * 256 * D + (size_t)(kt * 128) * D + nt * 128; d.dst = (bf16_t*)(wl + O_WBR) + (size_t)(nt * 128) * D + 768 + kt * 128; return d; }
    r -= 32;
    if (r < 128) { const int kt = r >> 4, nt = r & 15; d.Nsrc = D; d.K = D;
        d.src = p.in[16] + (size_t)l * 1024 * D + (size_t)(kt * 128) * D + nt * 128; d.dst = (bf16_t*)(wl + O_WBR) + (size_t)(nt * 128) * D + 1024 + kt * 128; return d; }
    r -= 128;
    if (r < 256) { const int kt = r >> 4, nt = r & 15; d.Nsrc = D; d.K = D;
        d.src = p.in[17] + (size_t)l * D * D + (size_t)(kt * 128) * D + nt * 128; d.dst = (bf16_t*)(wl + O_WOUT) + (size_t)(nt * 128) * D + kt * 128; return d; }
    r -= 256;
    if (r < 1408) { const int kt = r / 88, nt = r % 88; const int pn = nt >> 1, bj = nt & 1; d.Nsrc = 2 * DFF; d.K = D;
        d.src = p.in[18] + (size_t)l * D * 2 * DFF + (size_t)(kt * 128) * (2 * DFF) + bj * DFF + pn * 128; d.dst = (bf16_t*)(wl + O_WFI) + (size_t)(nt * 128) * D + kt * 128; return d; }
    r -= 1408;
    { const int kt = r >> 4, nt = r & 15; d.Nsrc = D; d.K = DFF;
      d.src = p.in[19] + (size_t)l * DFF * D + (size_t)(kt * 128) * D + nt * 128; d.dst = (bf16_t*)(wl + O_WFO) + (size_t)(nt * 128) * DFF + kt * 128; return d; }
}
__device__ __forceinline__ void conv_load(const ConvDesc& d, int tid, f32x4 (&v)[8]) {
#pragma unroll
    for (int i = 0; i < 8; ++i) {
        const int idx = tid + 512 * i, row = idx >> 5, c4 = idx & 31;
        v[i] = (f32x4){0.f, 0.f, 0.f, 0.f};
        if (c4 * 4 < d.nvalid) v[i] = __builtin_nontemporal_load((const f32x4*)(d.src + (size_t)row * d.Nsrc + c4 * 4));
    }
}
__device__ __forceinline__ void conv_phase(const Params& p, unsigned char* lds, int lo1, int n1, int lo2, int n2, int worker, int nworkers) {
    const int tid = tidx(), lane = tid & 63, w = tid >> 6;
    float* st = (float*)lds;
    const int ntot = n1 + n2;
    int v = worker;
    if (v >= ntot) return;
    ConvDesc d = conv_desc(p, v < n1 ? lo1 + v : lo2 + v - n1);
    f32x4 x4[8];
    conv_load(d, tid, x4);
    for (;;) {
#pragma unroll
        for (int i = 0; i < 8; ++i) {
            const int idx = tid + 512 * i; float* sp = st + (idx >> 5) * 129 + (idx & 31) * 4;
            sp[0] = x4[i][0]; sp[1] = x4[i][1]; sp[2] = x4[i][2]; sp[3] = x4[i][3];
        }
        __syncthreads();
        const ConvDesc dc = d;
        const int nx = v + nworkers; const bool more = nx < ntot;
        if (more) { d = conv_desc(p, nx < n1 ? lo1 + nx : lo2 + nx - n1); conv_load(d, tid, x4); }
        unsigned* dp = (unsigned*)(dc.dst + (size_t)(16 * w) * dc.K) + lane;
        const float* rp = st + (2 * lane) * 129 + 16 * w;
#pragma unroll
        for (int q = 0; q < 16; ++q) dp[(size_t)q * (dc.K >> 1)] = pk2(rp[q], rp[129 + q]);
        __syncthreads();
        if (!more) break;
        v = nx;
    }
}
constexpr int CV_DEF_A = 256, CV_DEF_B = 1280, CV_DEF_C = 3680, CV_DEF_D = 3936;

__device__ __forceinline__ void norm_phase(const float* __restrict__ xin, const float* __restrict__ gain, const float* __restrict__ shift, const float* __restrict__ scale, bf16_t* __restrict__ H) {
    const int tid = tidx(), lane = tid & 63, gw = bidx() * 8 + (tid >> 6), nw = gridDim.x * 8;
    for (int row = gw; row < T; row += nw) {
        const float* xr = xin + (size_t)row * D;
        f32x4 v[8]; float ss = 0.f;
#pragma unroll
        for (int i = 0; i < 8; ++i) { v[i] = *(const f32x4*)(xr + i * 256 + lane * 4); ss += v[i][0] * v[i][0] + v[i][1] * v[i][1] + v[i][2] * v[i][2] + v[i][3] * v[i][3]; }
#pragma unroll
        for (int o = 32; o > 0; o >>= 1) ss += shx(ss, o, lane);
        const float inv = rsqrtf(ss * (1.f / D) + EPS);
#pragma unroll
        for (int i = 0; i < 8; ++i) {
            const int c = i * 256 + lane * 4;
            const f32x4 g = *(const f32x4*)(gain + c), sh = *(const f32x4*)(shift + c), sc = *(const f32x4*)(scale + c);
            const f32x4 y = v[i] * inv * g * (1.f + sc) + sh;
            u32x2 o = {pk2(y[0], y[1]), pk2(y[2], y[3])};
            *(u32x2*)(H + (size_t)row * D + c) = o;
        }
    }
}

template <int nkeys> __device__ __forceinline__ void stage_vt(bf16_t* VT, int pitch, const bf16_t* P, int r0, int rstride, int col, int nch) {
    const int tid = tidx();
    for (int idx = tid; idx < nkeys * nch; idx += 512) {
        const int key = idx % nkeys, ch = idx / nkeys;
        const u32x4 raw = *(const u32x4*)(P + pidx(r0 + key * rstride, col + ch * 8));
        bf16_t* d = VT + (ch * 8) * pitch + key;
        d[0] = (bf16_t)(raw[0] & 0xffff); d[pitch] = (bf16_t)(raw[0] >> 16); d[2 * pitch] = (bf16_t)(raw[1] & 0xffff); d[3 * pitch] = (bf16_t)(raw[1] >> 16);
        d[4 * pitch] = (bf16_t)(raw[2] & 0xffff); d[5 * pitch] = (bf16_t)(raw[2] >> 16); d[6 * pitch] = (bf16_t)(raw[3] & 0xffff); d[7 * pitch] = (bf16_t)(raw[3] >> 16);
    }
}
__device__ __forceinline__ void stage_rows128_norm(bf16_t* dst, const bf16_t* P, int r0, int rstride, int col, const float* __restrict__ gain, float qs) {
    const int tid = tidx(), lane = tid & 63;
    const f32x4 g0 = *(const f32x4*)(gain + (tid & 15) * 8), g1 = *(const f32x4*)(gain + (tid & 15) * 8 + 4);
#pragma unroll
    for (int i = 0; i < 4; ++i) {
        const int idx = tid + 512 * i, r = idx >> 4, ch = idx & 15;
        const u32x4 raw = *(const u32x4*)(P + pidx(r0 + r * rstride, col + ch * 8));
        float v[8] = {bflo(raw[0]), bfhi(raw[0]), bflo(raw[1]), bfhi(raw[1]), bflo(raw[2]), bfhi(raw[2]), bflo(raw[3]), bfhi(raw[3])};
        float ss = 0.f;
#pragma unroll
        for (int j = 0; j < 8; ++j) ss += v[j] * v[j];
        ss += shx(ss, 1, lane); ss += shx(ss, 2, lane); ss += shx(ss, 4, lane); ss += shx(ss, 8, lane);
        const float inv = rsqrtf(ss * (1.f / 128.f) + EPS) * qs;
        u32x4 o = {pk2(v[0] * inv * g0[0], v[1] * inv * g0[1]), pk2(v[2] * inv * g0[2], v[3] * inv * g0[3]),
                   pk2(v[4] * inv * g1[0], v[5] * inv * g1[1]), pk2(v[6] * inv * g1[2], v[7] * inv * g1[3])};
        *(u32x4*)(dst + r * 136 + ch * 8) = o;
    }
}
__device__ __forceinline__ void pv_tile(f32x4 (&oacc)[8], const bf16_t* VT, int pitch, int koff, const float (&w)[4][4], int fr, int fq) {
    bf16x8 pf[2];
#pragma unroll
    for (int kb = 0; kb < 2; ++kb) pf[kb] = mk8(pk2(w[2 * kb][0], w[2 * kb][1]), pk2(w[2 * kb][2], w[2 * kb][3]), pk2(w[2 * kb + 1][0], w[2 * kb + 1][1]), pk2(w[2 * kb + 1][2], w[2 * kb + 1][3]));
#pragma unroll
    for (int db = 0; db < 8; ++db)
#pragma unroll
        for (int kb = 0; kb < 2; ++kb) {
            const bf16_t* vp = VT + (16 * db + fr) * pitch + koff + 32 * kb + 4 * fq;
            const u32x2 lo = *(const u32x2*)vp, hi = *(const u32x2*)(vp + 16);
            oacc[db] = mfma16(mk8(lo[0], lo[1], hi[0], hi[1]), pf[kb], oacc[db]);
        }
}

constexpr int AT_Q = 0, AT_BUF = 34816, AT_BUFSZ = 17408 + 18432, AT_VOFF = 17408, AT_F = AT_BUF + 2 * AT_BUFSZ;
struct TileRegs { u32x4 k[2], v[2]; };
__device__ __forceinline__ void tile_load(TileRegs& t, const bf16_t* P, int r0, int rstride, int kcol, int vcol, int tid) {
#pragma unroll
    for (int i = 0; i < 2; ++i) {
        const int idx = tid + 512 * i;
        t.k[i] = *(const u32x4*)(P + pidx(r0 + (idx >> 4) * rstride, kcol + (idx & 15) * 8));
        t.v[i] = *(const u32x4*)(P + pidx(r0 + (idx & 63) * rstride, vcol + (idx >> 6) * 8));
    }
}
__device__ __forceinline__ void tile_write(const TileRegs& t, unsigned char* buf, const f32x4& g0, const f32x4& g1, int tid, int lane) {
    bf16_t* Ks = (bf16_t*)buf; bf16_t* VT = (bf16_t*)(buf + AT_VOFF);
#pragma unroll
    for (int i = 0; i < 2; ++i) {
        const int idx = tid + 512 * i, r = idx >> 4, ch = idx & 15;
        const u32x4 raw = t.k[i];
        float v[8] = {bflo(raw[0]), bfhi(raw[0]), bflo(raw[1]), bfhi(raw[1]), bflo(raw[2]), bfhi(raw[2]), bflo(raw[3]), bfhi(raw[3])};
        float ss = 0.f;
#pragma unroll
        for (int j = 0; j < 8; ++j) ss += v[j] * v[j];
        ss += shx(ss, 1, lane); ss += shx(ss, 2, lane); ss += shx(ss, 4, lane); ss += shx(ss, 8, lane);
        const float inv = rsqrtf(ss * (1.f / 128.f) + EPS);
        u32x4 o = {pk2(v[0] * inv * g0[0], v[1] * inv * g0[1]), pk2(v[2] * inv * g0[2], v[3] * inv * g0[3]),
                   pk2(v[4] * inv * g1[0], v[5] * inv * g1[1]), pk2(v[6] * inv * g1[2], v[7] * inv * g1[3])};
        *(u32x4*)(Ks + r * 136 + ch * 8) = o;
        const u32x4 rv = t.v[i];
        bf16_t* d = VT + ((idx >> 6) * 8) * 72 + (idx & 63);
        d[0] = (bf16_t)(rv[0] & 0xffff); d[72] = (bf16_t)(rv[0] >> 16); d[144] = (bf16_t)(rv[1] & 0xffff); d[216] = (bf16_t)(rv[1] >> 16);
        d[288] = (bf16_t)(rv[2] & 0xffff); d[360] = (bf16_t)(rv[2] >> 16); d[432] = (bf16_t)(rv[3] & 0xffff); d[504] = (bf16_t)(rv[3] >> 16);
    }
}

__device__ __forceinline__ void sb_item(const Params& p, int item, int l, unsigned char* lds) {
    const int tid = tidx(), w = tid >> 6, lane = tid & 63, fr = lane & 15, fq = lane >> 4;
    const bf16_t* P = (const bf16_t*)(p.ws + W_PROJ);
    bf16_t* OSB = (bf16_t*)(p.ws + W_OCAT);
    const int head = item >> 6, I = 63 - (item & 63);
    bf16_t* Qs = (bf16_t*)(lds + AT_Q); float* flags = (float*)(lds + AT_F);
    const float* gq = p.in[7] + l * 128; const float* gk = p.in[8] + l * 128;
    const f32x4 gk0 = *(const f32x4*)(gk + (tid & 15) * 8), gk1 = *(const f32x4*)(gk + (tid & 15) * 8 + 4);
    const int kcol = C_KSB + head * 128, vcol = C_VSB + head * 128;
    __syncthreads();
    TileRegs tr;
    int J = 2 * I + 1;
    tile_load(tr, P, 64 * J, 1, kcol, vcol, tid);
    stage_rows128_norm(Qs, P, 128 * I, 1, C_QSB + head * 128, gq, 0.08838834764831845f);
    tile_write(tr, lds + AT_BUF, gk0, gk1, tid, lane);
    tile_load(tr, P, 64 * (J - 1), 1, kcol, vcol, tid);
    __syncthreads();
    bf16x8 qf[4];
#pragma unroll
    for (int ks = 0; ks < 4; ++ks) qf[ks] = *(const bf16x8*)(Qs + (16 * w + fr) * 136 + 32 * ks + 8 * fq);
    f32x4 oacc[8];
#pragma unroll
    for (int db = 0; db < 8; ++db) oacc[db] = (f32x4){0.f, 0.f, 0.f, 0.f};
    float R = 1.f;
    const int tq = 128 * I + 16 * w + fr;
    constexpr float SB_EXIT = 1e-9f;
    int cur = 0;
    for (;;) {
        const bf16_t* Ks = (const bf16_t*)(lds + AT_BUF + cur * AT_BUFSZ); const bf16_t* VT = (const bf16_t*)(lds + AT_BUF + cur * AT_BUFSZ + AT_VOFF);
        const bool allmasked = 64 * J >= 128 * I + 16 * w + 15;
        if (!allmasked) {
            f32x4 s[4];
#pragma unroll
            for (int b = 0; b < 4; ++b) {
                s[b] = (f32x4){0.f, 0.f, 0.f, 0.f};
#pragma unroll
                for (int ks = 0; ks < 4; ++ks) s[b] = mfma16(*(const bf16x8*)(Ks + (16 * b + fr) * 136 + 32 * ks + 8 * fq), qf[ks], s[b]);
            }
            float beta[4][4], omb[4][4], lat[4], tot[4], wgt[4][4];
#pragma unroll
            for (int b = 0; b < 4; ++b) {
#pragma unroll
                for (int r = 0; r < 4; ++r) {
                    const int key = 64 * J + 16 * b + 4 * fq + r;
                    const float z = fminf(fmaxf(s[b][r], -80.f), 80.f);
                    const float e = __expf(-z), bt = __builtin_amdgcn_rcpf(1.f + e);
                    const bool valid = key < tq;
                    beta[b][r] = valid ? bt : 0.f; omb[b][r] = valid ? e * bt : 1.f;
                }
                const float g = omb[b][0] * omb[b][1] * omb[b][2] * omb[b][3];
                const float g1 = shx(g, 16, lane), g2 = shx(g, 32, lane), g3 = shx(g, 48, lane);
                lat[b] = fq == 0 ? g1 * g2 * g3 : (fq == 1 ? g2 * g3 : (fq == 2 ? g1 : 1.f));
                tot[b] = g * g1 * g2 * g3;
            }
            float cb = R;
#pragma unroll
            for (int b = 3; b >= 0; --b) {
                float c = cb * lat[b];
#pragma unroll
                for (int r = 3; r >= 0; --r) { wgt[b][r] = beta[b][r] * c; c *= omb[b][r]; }
                cb *= tot[b];
            }
            R = cb;
            pv_tile(oacc, VT, 72, 0, wgt, fr, fq);
        }
        float rm = R;
#pragma unroll
        for (int o = 32; o > 0; o >>= 1) rm = fmaxf(rm, shx(rm, o, lane));
        if (lane == 0) flags[cur * 8 + w] = rm;
        if (J == 0) break;
        tile_write(tr, lds + AT_BUF + (cur ^ 1) * AT_BUFSZ, gk0, gk1, tid, lane);
        if (J >= 2) tile_load(tr, P, 64 * (J - 2), 1, kcol, vcol, tid);
        __syncthreads();
        float mx = 0.f;
#pragma unroll
        for (int q = 0; q < 8; ++q) mx = fmaxf(mx, flags[cur * 8 + q]);
        if (mx < SB_EXIT) break;
        cur ^= 1; --J;
    }
    bf16_t* op = OSB + (size_t)tq * D + head * 128 + 4 * fq;
#pragma unroll
    for (int db = 0; db < 8; ++db) { u32x2 o = {pk2(oacc[db][0], oacc[db][1]), pk2(oacc[db][2], oacc[db][3])}; *(u32x2*)(op + 16 * db) = o; }
}

__device__ __forceinline__ void dil_item(const Params& p, int item, int l, unsigned char* lds) {
    const int tid = tidx(), w = tid >> 6, lane = tid & 63, fr = lane & 15, fq = lane >> 4;
    const bf16_t* P = (const bf16_t*)(p.ws + W_PROJ);
    float* ODG = (float*)(p.ws + W_ODG); float* LSE = (float*)(p.ws + W_LSE);
    const int g = item >> 7, rem = item & 127, hh = rem >> 6, s6 = rem & 63;
    const int r = g == 0 ? 1 : (g == 1 ? 4 : 16), nb = 64 / r, rho = s6 / nb, n = s6 % nb;
    const int head = 2 * g + hh;
    const float slope = exp2f(-8.f * (float)(head + 1) / 6.f) * (float)r;
    bf16_t* Qs = (bf16_t*)(lds + AT_Q);
    const float* gq = p.in[9] + l * 128; const float* gk = p.in[10] + l * 128;
    const f32x4 gk0 = *(const f32x4*)(gk + (tid & 15) * 8), gk1 = *(const f32x4*)(gk + (tid & 15) * 8 + 4);
    const int kcol = C_KDIL + head * 128, vcol = C_VDIL + head * 128;
    __syncthreads();
    TileRegs tr;
    int c = n == 0 ? 2 : 0;
    tile_load(tr, P, (128 * (n - 1) + 64 * c) * r + rho, r, kcol, vcol, tid);
    stage_rows128_norm(Qs, P, (128 * n) * r + rho, r, C_QDIL + head * 128, gq, 0.08838834764831845f);
    tile_write(tr, lds + AT_BUF, gk0, gk1, tid, lane);
    tile_load(tr, P, (128 * (n - 1) + 64 * (c + 1)) * r + rho, r, kcol, vcol, tid);
    __syncthreads();
    bf16x8 qf[4];
#pragma unroll
    for (int ks = 0; ks < 4; ++ks) qf[ks] = *(const bf16x8*)(Qs + (16 * w + fr) * 136 + 32 * ks + 8 * fq);
    f32x4 oacc[8];
#pragma unroll
    for (int db = 0; db < 8; ++db) oacc[db] = (f32x4){0.f, 0.f, 0.f, 0.f};
    float lsum = 0.f;
    const int iq = 16 * w + fr;
    int cur = 0;
    for (;;) {
        const bf16_t* Ks = (const bf16_t*)(lds + AT_BUF + cur * AT_BUFSZ); const bf16_t* VT = (const bf16_t*)(lds + AT_BUF + cur * AT_BUFSZ + AT_VOFF);
        const int dmax = 128 + 16 * w + 15 - 64 * c, dmin = 128 + 16 * w - 64 * c - 63;
        if (!(dmax < 0 || dmin > 128)) {
            float wgt[4][4];
#pragma unroll
            for (int b = 0; b < 4; ++b) {
                f32x4 sc = {0.f, 0.f, 0.f, 0.f};
#pragma unroll
                for (int ks = 0; ks < 4; ++ks) sc = mfma16(*(const bf16x8*)(Ks + (16 * b + fr) * 136 + 32 * ks + 8 * fq), qf[ks], sc);
#pragma unroll
                for (int q = 0; q < 4; ++q) {
                    const int delta = 128 + iq - 64 * c - (16 * b + 4 * fq + q);
                    const bool valid = delta >= 0 && delta <= 128;
                    const float pe = valid ? __expf(sc[q] - slope * (float)delta) : 0.f;
                    wgt[b][q] = pe; lsum += pe;
                }
            }
            pv_tile(oacc, VT, 72, 0, wgt, fr, fq);
        }
        if (c == 3) break;
        tile_write(tr, lds + AT_BUF + (cur ^ 1) * AT_BUFSZ, gk0, gk1, tid, lane);
        if (c + 2 <= 3) tile_load(tr, P, (128 * (n - 1) + 64 * (c + 2)) * r + rho, r, kcol, vcol, tid);
        __syncthreads();
        cur ^= 1; ++c;
    }
    lsum += shx(lsum, 16, lane); lsum += shx(lsum, 32, lane);
    const float inv = 1.f / lsum;
    const int t = (128 * n + iq) * r + rho;
    float* op = ODG + ((size_t)g * T + t) * 256 + hh * 128 + 4 * fq;
#pragma unroll
    for (int db = 0; db < 8; ++db) *(f32x4*)(op + 16 * db) = oacc[db] * inv;
    if (fq == 0) LSE[(size_t)(g * 2 + hh) * T + t] = __logf(lsum);
}

__device__ __forceinline__ void gla1_item(const Params& p, int item, int l, unsigned char* lds) {
    const int tid = tidx(), w = tid >> 6, lane = tid & 63, fr = lane & 15, fq = lane >> 4;
    const bf16_t* P = (const bf16_t*)(p.ws + W_PROJ);
    const float* agla = (const float*)(p.ws + W_AGLA);
    float* DL = (float*)(p.ws + W_DL); bf16_t* U = (bf16_t*)(p.ws + W_U); float* CUM = (float*)(p.ws + W_CUM);
    const float* wa = p.in[11] + (size_t)l * 16 * 512; const float* ba = p.in[12] + l * 512;
    const int h = item >> 7, n = item & 127, t0 = 64 * n;
    float* cum = (float*)lds; bf16_t* Kr = (bf16_t*)(lds + 32768); bf16_t* KT = (bf16_t*)(lds + 50176); bf16_t* VT = (bf16_t*)(lds + 68608); float* segt = (float*)(lds + 105472);
    __syncthreads();
    {
        const int d = tid & 127, c0 = tid >> 7;
        float wv[16];
#pragma unroll
        for (int q = 0; q < 16; ++q) wv[q] = wa[q * 512 + h * 128 + d];
        const float bias = ba[h * 128 + d];
#pragma unroll 4
        for (int i = 0; i < 16; ++i) {
            const int c = c0 + 4 * i;
            const float* ar = agla + (size_t)(t0 + c) * 16;
            float a = bias;
#pragma unroll
            for (int q4 = 0; q4 < 4; ++q4) { const f32x4 t4 = *(const f32x4*)(ar + q4 * 4); a += t4[0] * wv[q4 * 4] + t4[1] * wv[q4 * 4 + 1] + t4[2] * wv[q4 * 4 + 2] + t4[3] * wv[q4 * 4 + 3]; }
            const float ls = fminf(a, 0.f) - __logf(1.f + __expf(-fabsf(a)));
            cum[c * 128 + d] = ls * (1.f / 16.f);
        }
    }
    for (int idx = tid; idx < 1024; idx += 512) {
        const int r = idx >> 4, ch = idx & 15;
        *(u32x4*)(Kr + r * 136 + ch * 8) = *(const u32x4*)(P + pidx(t0 + r, C_KG + h * 128 + ch * 8));
    }
    stage_vt<64>(VT, 72, P, t0, 1, C_VG + h * 256, 32);
    __syncthreads();
    {
        const int d = tid & 127, sg = tid >> 7;
        float v[16]; float run = 0.f;
#pragma unroll
        for (int i = 0; i < 16; ++i) { run += cum[(16 * sg + i) * 128 + d]; v[i] = run; }
        segt[sg * 128 + d] = run;
        __syncthreads();
        float off = 0.f;
#pragma unroll
        for (int q = 0; q < 3; ++q) off += (q < sg) ? segt[q * 128 + d] : 0.f;
#pragma unroll
        for (int i = 0; i < 16; ++i) { const float c = v[i] + off; cum[(16 * sg + i) * 128 + d] = c; CUM[(size_t)(t0 + 16 * sg + i) * 512 + h * 128 + d] = c; }
        if (sg == 3) DL[(size_t)(h * 128 + n) * 128 + d] = __expf(v[15] + off);
    }
    __syncthreads();
    for (int idx = tid; idx < 1024; idx += 512) {
        const int key = idx & 63, ch = idx >> 6;
        const u32x4 raw = *(const u32x4*)(Kr + key * 136 + ch * 8);
        const float kv[8] = {bflo(raw[0]), bfhi(raw[0]), bflo(raw[1]), bfhi(raw[1]), bflo(raw[2]), bfhi(raw[2]), bflo(raw[3]), bfhi(raw[3])};
#pragma unroll
        for (int e = 0; e < 8; ++e) {
            const int d = ch * 8 + e;
            const float f = __expf(cum[63 * 128 + d] - cum[key * 128 + d]);
            KT[d * 72 + key] = (bf16_t)(pk2(kv[e] * f, 0.f) & 0xffff);
        }
    }
    __syncthreads();
    bf16x8 kf[2];
#pragma unroll
    for (int ks = 0; ks < 2; ++ks) kf[ks] = *(const bf16x8*)(KT + (16 * w + fr) * 72 + 32 * ks + 8 * fq);
    bf16_t* up = U + ((size_t)(h * 128 + n) * 256 + fr) * 128 + 16 * w + 4 * fq;
#pragma unroll
    for (int eb = 0; eb < 16; ++eb) {
        f32x4 a = {0.f, 0.f, 0.f, 0.f};
#pragma unroll
        for (int ks = 0; ks < 2; ++ks) a = mfma16(kf[ks], *(const bf16x8*)(VT + (16 * eb + fr) * 72 + 32 * ks + 8 * fq), a);
        u32x2 o = {pk2(a[0], a[1]), pk2(a[2], a[3])};
        *(u32x2*)(up + (size_t)(16 * eb) * 128) = o;
    }
}

__device__ __forceinline__ void gla2_phase(const Params& p) {
    const float* DL = (const float*)(p.ws + W_DL); const bf16_t* U = (const bf16_t*)(p.ws + W_U); bf16_t* SP = (bf16_t*)(p.ws + W_SP);
    const int total = gridDim.x * 512;
    for (int idx = bidx() * 512 + tidx(); idx < 4 * 32768; idx += total) {
        const int h = idx >> 15, ed = idx & 32767, d = ed & 127;
        const bf16_t* up = U + (size_t)h * 128 * 32768 + ed; bf16_t* sp = SP + (size_t)h * 128 * 32768 + ed; const float* dp = DL + (size_t)h * 128 * 128 + d;
        float S = 0.f;
        for (int n0 = 0; n0 < 128; n0 += 16) {
            float tv[16], dv[16];
#pragma unroll
            for (int q = 0; q < 16; ++q) { tv[q] = bf1(up[(size_t)(n0 + q) * 32768]); dv[q] = dp[(n0 + q) * 128]; }
#pragma unroll
            for (int q = 0; q < 16; ++q) { sp[(size_t)(n0 + q) * 32768] = (bf16_t)(pk2(S, 0.f) & 0xffff); S = dv[q] * S + tv[q]; }
        }
    }
}

__device__ __forceinline__ void gla3_item(const Params& p, int item, int l, unsigned char* lds) {
    const int tid = tidx(), w = tid >> 6, lane = tid & 63, fr = lane & 15, fq = lane >> 4;
    const bf16_t* P = (const bf16_t*)(p.ws + W_PROJ);
    const float* cumg = (const float*)(p.ws + W_CUM);
    bf16_t* OG = (bf16_t*)(p.ws + W_OCAT) + 1024;
    const float* ogain = p.in[13] + l * 256;
    const int h = item >> 7, n = item & 127, t0 = 64 * n;
    float* cum = (float*)lds; bf16_t* ST = (bf16_t*)lds;
    bf16_t* Qp = (bf16_t*)(lds + 69632); bf16_t* Kp = (bf16_t*)(lds + 87040); bf16_t* VT = (bf16_t*)(lds + 104448);
    float* c31 = (float*)(lds + 141312); float* ssq = (float*)(lds + 141824);
    __syncthreads();
#pragma unroll
    for (int i = 0; i < 4; ++i) { const int idx = tid + 512 * i, c = idx >> 5, d4 = idx & 31; *(f32x4*)(cum + c * 128 + d4 * 4) = *(const f32x4*)(cumg + (size_t)(t0 + c) * 512 + h * 128 + d4 * 4); }
    u32x4 rq[2], rk[2];
#pragma unroll
    for (int i = 0; i < 2; ++i) {
        const int idx = tid + 512 * i, c = idx >> 4, ch = idx & 15;
        rq[i] = *(const u32x4*)(P + pidx(t0 + c, C_QG + h * 128 + ch * 8));
        rk[i] = *(const u32x4*)(P + pidx(t0 + c, C_KG + h * 128 + ch * 8));
    }
    stage_vt<64>(VT, 72, P, t0, 1, C_VG + h * 256, 32);
    __syncthreads();
    const bf16_t* sp = (const bf16_t*)(p.ws + W_SP) + (size_t)(h * 128 + n) * 32768;
    u32x4 sv[8];
#pragma unroll
    for (int i = 0; i < 8; ++i) { const int idx = tid + 512 * i, e = idx >> 4, ch = idx & 15; sv[i] = *(const u32x4*)(sp + e * 128 + ch * 8); }
    float f31[8];
    {
        const int ch = tid & 15;
#pragma unroll
        for (int j = 0; j < 8; ++j) f31[j] = __expf(cum[31 * 128 + ch * 8 + j]);
    }
#pragma unroll
    for (int i = 0; i < 2; ++i) {
        const int idx = tid + 512 * i, c = idx >> 4, ch = idx & 15;
        const float qv[8] = {bflo(rq[i][0]), bfhi(rq[i][0]), bflo(rq[i][1]), bfhi(rq[i][1]), bflo(rq[i][2]), bfhi(rq[i][2]), bflo(rq[i][3]), bfhi(rq[i][3])};
        const float kv[8] = {bflo(rk[i][0]), bfhi(rk[i][0]), bflo(rk[i][1]), bfhi(rk[i][1]), bflo(rk[i][2]), bfhi(rk[i][2]), bflo(rk[i][3]), bfhi(rk[i][3])};
        float qo[8], ko[8];
#pragma unroll
        for (int e = 0; e < 8; ++e) {
            const int d = ch * 8 + e;
            const float df = cum[c * 128 + d] - cum[31 * 128 + d];
            qo[e] = qv[e] * 0.08838834764831845f * __expf(df); ko[e] = kv[e] * __expf(-df);
        }
        u32x4 oq = {pk2(qo[0], qo[1]), pk2(qo[2], qo[3]), pk2(qo[4], qo[5]), pk2(qo[6], qo[7])};
        u32x4 ok = {pk2(ko[0], ko[1]), pk2(ko[2], ko[3]), pk2(ko[4], ko[5]), pk2(ko[6], ko[7])};
        *(u32x4*)(Qp + c * 136 + ch * 8) = oq; *(u32x4*)(Kp + c * 136 + ch * 8) = ok;
    }
    __syncthreads();
#pragma unroll
    for (int i = 0; i < 8; ++i) {
        const int idx = tid + 512 * i, e = idx >> 4, ch = idx & 15;
        u32x4 o = {pk2(bflo(sv[i][0]) * f31[0], bfhi(sv[i][0]) * f31[1]), pk2(bflo(sv[i][1]) * f31[2], bfhi(sv[i][1]) * f31[3]),
                   pk2(bflo(sv[i][2]) * f31[4], bfhi(sv[i][2]) * f31[5]), pk2(bflo(sv[i][3]) * f31[6], bfhi(sv[i][3]) * f31[7])};
        *(u32x4*)(ST + e * 136 + ch * 8) = o;
    }
    __syncthreads();
    const int ib = w & 3, eh = w >> 2, iq = 16 * ib + fr;
    bf16x8 qf[4];
#pragma unroll
    for (int ks = 0; ks < 4; ++ks) qf[ks] = *(const bf16x8*)(Qp + iq * 136 + 32 * ks + 8 * fq);
    float wgt[4][4];
#pragma unroll
    for (int jb = 0; jb < 4; ++jb) {
        f32x4 s = {0.f, 0.f, 0.f, 0.f};
        if (jb <= ib) {
#pragma unroll
            for (int ks = 0; ks < 4; ++ks) s = mfma16(*(const bf16x8*)(Kp + (16 * jb + fr) * 136 + 32 * ks + 8 * fq), qf[ks], s);
        }
#pragma unroll
        for (int q = 0; q < 4; ++q) wgt[jb][q] = (16 * jb + 4 * fq + q <= iq) ? s[q] : 0.f;
    }
    bf16x8 pf[2];
#pragma unroll
    for (int kb = 0; kb < 2; ++kb) pf[kb] = mk8(pk2(wgt[2 * kb][0], wgt[2 * kb][1]), pk2(wgt[2 * kb][2], wgt[2 * kb][3]), pk2(wgt[2 * kb + 1][0], wgt[2 * kb + 1][1]), pk2(wgt[2 * kb + 1][2], wgt[2 * kb + 1][3]));
    f32x4 o[8]; float sq = 0.f;
#pragma unroll
    for (int ebl = 0; ebl < 8; ++ebl) {
        const int eb = 8 * eh + ebl;
        f32x4 a = {0.f, 0.f, 0.f, 0.f};
#pragma unroll
        for (int ks = 0; ks < 4; ++ks) a = mfma16(*(const bf16x8*)(ST + (16 * eb + fr) * 136 + 32 * ks + 8 * fq), qf[ks], a);
#pragma unroll
        for (int kb = 0; kb < 2; ++kb) {
            const bf16_t* vp = VT + (16 * eb + fr) * 72 + 32 * kb + 4 * fq;
            const u32x2 lo = *(const u32x2*)vp, hi = *(const u32x2*)(vp + 16);
            a = mfma16(mk8(lo[0], lo[1], hi[0], hi[1]), pf[kb], a);
        }
        o[ebl] = a; sq += a[0] * a[0] + a[1] * a[1] + a[2] * a[2] + a[3] * a[3];
    }
    sq += shx(sq, 16, lane); sq += shx(sq, 32, lane);
    if (fq == 0) ssq[eh * 64 + iq] = sq;
    __syncthreads();
    const float rinv = rsqrtf((ssq[iq] + ssq[64 + iq]) * (1.f / 256.f) + EPS);
    const size_t trow = (size_t)(t0 + iq);
#pragma unroll
    for (int ebl = 0; ebl < 8; ++ebl) {
        const int e = 16 * (8 * eh + ebl) + 4 * fq;
        const u32x2 rr = *(const u32x2*)(P + pidx((int)trow, C_RG + h * 256 + e));
        const f32x4 gn = *(const f32x4*)(ogain + e);
        const float y0 = o[ebl][0] * rinv * gn[0] * siluf_(bflo(rr[0])), y1 = o[ebl][1] * rinv * gn[1] * siluf_(bfhi(rr[0]));
        const float y2 = o[ebl][2] * rinv * gn[2] * siluf_(bflo(rr[1])), y3 = o[ebl][3] * rinv * gn[3] * siluf_(bfhi(rr[1]));
        u32x2 ov = {pk2(y0, y1), pk2(y2, y3)};
        *(u32x2*)(OG + trow * D + h * 256 + e) = ov;
    }
}

__device__ __forceinline__ void dilmix_phase(const Params& p) {
    const float* ODG = (const float*)(p.ws + W_ODG); const float* LSE = (const float*)(p.ws + W_LSE);
    bf16_t* OD = (bf16_t*)(p.ws + W_OCAT) + 768;
    const int total = gridDim.x * 512;
    for (int idx = bidx() * 512 + tidx(); idx < T * 64; idx += total) {
        const int t = idx >> 6, c4 = idx & 63, hh = c4 >> 5;
        const float l0 = LSE[(size_t)(0 + hh) * T + t], l1 = LSE[(size_t)(2 + hh) * T + t], l2 = LSE[(size_t)(4 + hh) * T + t];
        const float m = fmaxf(l0, fmaxf(l1, l2));
        const float e0 = __expf(l0 - m), e1 = __expf(l1 - m), e2 = __expf(l2 - m), inv = 1.f / (e0 + e1 + e2);
        const f32x4 a0 = *(const f32x4*)(ODG + ((size_t)0 * T + t) * 256 + c4 * 4), a1 = *(const f32x4*)(ODG + ((size_t)1 * T + t) * 256 + c4 * 4), a2 = *(const f32x4*)(ODG + ((size_t)2 * T + t) * 256 + c4 * 4);
        const f32x4 y = (a0 * e0 + a1 * e1 + a2 * e2) * inv;
        u32x2 o = {pk2(y[0], y[1]), pk2(y[2], y[3])};
        *(u32x2*)(OD + (size_t)t * D + c4 * 4) = o;
    }
}

#define XB_TMO      128
#define XB_XCNT(j)  (256  + 64 * (j))
#define XB_XSUB(j)  (1280 + 64 * (j))
#define XB_XGEN(j)  (2304 + 64 * (j))
#define XB_TOP      3328
#define XB_TOPGEN   3392
#define XCD_BAR_WORDS 3456
#define XB_SPIN_CAP (1u << 18)
__device__ __forceinline__ unsigned xb_xcc_id() { return (unsigned)__builtin_amdgcn_s_getreg((3 << 11) | 20) & 0xFu; }
#define XB_SPIN(cond, bar) do { unsigned _sp = 0; while (cond) { __builtin_amdgcn_s_sleep(1); \
    if ((++_sp & 255u) == 0u) { if (xb_ld(&(bar)[XB_TMO])) break; if (_sp > XB_SPIN_CAP) { atomicAdd(&(bar)[XB_TMO], 1u); break; } } } } while (0)
struct XcdBarrier { unsigned* bar; unsigned x; volatile LAS unsigned* st; };
__device__ __forceinline__ XcdBarrier xcd_barrier_post(unsigned* bar, volatile LAS unsigned* st) {
    XcdBarrier b; b.bar = bar; b.x = xb_xcc_id(); b.st = st;
    if (threadIdx.x == 0) st[3] = xb_add(&bar[XB_XCNT(b.x)], 1u);
    return b;
}
__device__ __forceinline__ void xcd_barrier_complete(unsigned* bar, unsigned x, unsigned& nloc, unsigned& nx) {
    const unsigned G = gridDim.x * gridDim.y * gridDim.z;
    unsigned sum, cnt, mine, sp = 0u;
    for (;;) {
        sum = 0u; cnt = 0u; mine = 0u;
#pragma unroll
        for (unsigned j = 0; j < 16; ++j) { const unsigned c = xb_ld(&bar[XB_XCNT(j)]); sum += c; cnt += (c > 0u) ? 1u : 0u; mine = (j == x) ? c : mine; }
        if (sum == G) break;
        __builtin_amdgcn_s_sleep(1);
        if ((++sp & 255u) == 0u) { if (xb_ld(&bar[XB_TMO])) break; if (sp > XB_SPIN_CAP) { atomicAdd(&bar[XB_TMO], 1u); break; } }
    }
    nloc = mine > 0u ? mine : 1u; nx = cnt > 0u ? cnt : 1u;
}
__device__ __forceinline__ void xcd_barrier(const XcdBarrier& b) {
    asm volatile("s_waitcnt vmcnt(0)" ::: "memory");
    __syncthreads();
    if (threadIdx.x == 0) {
        unsigned* bar = b.bar; asm volatile("" : "+s"(bar));
        __builtin_amdgcn_s_waitcnt(0);
        unsigned nloc = b.st[0], nx = b.st[1];
        if (nloc == 0u) { xcd_barrier_complete(bar, b.x, nloc, nx); b.st[0] = nloc; b.st[1] = nx; }
        const unsigned old = xb_add(&bar[XB_XSUB(b.x)], 1u);
        const unsigned gen = old / nloc;
        if (old + 1u == (gen + 1u) * nloc) {
            __builtin_amdgcn_fence(__ATOMIC_RELEASE, "agent");
            asm volatile("s_waitcnt vmcnt(0)" ::: "memory");
            const unsigned og = xb_add(&bar[XB_TOP], 1u);
            const unsigned tg = og / nx;
            if (og + 1u == (tg + 1u) * nx) xb_add(&bar[XB_TOPGEN], 1u);
            else XB_SPIN(xb_ld(&bar[XB_TOPGEN]) == tg, bar);
            __builtin_amdgcn_fence(__ATOMIC_ACQUIRE, "agent");
            asm volatile("s_waitcnt vmcnt(0)" ::: "memory");
        } else {
            XB_SPIN(xb_ld(&bar[XB_TOPGEN]) == gen, bar);
            __builtin_amdgcn_fence(__ATOMIC_ACQUIRE, "agent");
            asm volatile("s_waitcnt vmcnt(0)" ::: "memory");
        }
    }
    __syncthreads();
}

constexpr int PH_PER_LAYER = 10, N_PHASES = 1 + 2 * PH_PER_LAYER;

__device__ __forceinline__ void gemm_job(const Params& p, int l, int gi, unsigned char* lds) {
    unsigned char* wl = p.ws + (size_t)l * SZ_WL;
    pg8::Gemm g; EpiAny E{0, false, l, p, false};
    const bool canfuse = gridDim.x == 256;
    g.M = T; g.N = D; g.K = D; g.A = (const bf16_t*)(p.ws + W_H); g.Bt = (const bf16_t*)wl;
    if (gi == 0) { g.N = NINP; g.Bt = (const bf16_t*)(wl + O_WIN); E.mode = 0; E.PERM = true; }
    else if (gi == 1) { g.A = (const bf16_t*)(p.ws + W_OCAT); g.Bt = (const bf16_t*)(wl + O_WBR); E.mode = 1; E.PERM = true; }
    else if (gi == 2) { g.A = (const bf16_t*)(p.ws + W_YB); g.Bt = (const bf16_t*)(wl + O_WOUT); E.mode = 4; E.PERM = true; E.fuse = canfuse; }
    else if (gi == 3) { g.N = 2 * DFF; g.Bt = (const bf16_t*)(wl + O_WFI); E.mode = 5; E.PERM = true; }
    else { g.K = DFF; g.A = (const bf16_t*)(p.ws + W_PROJ); g.Bt = (const bf16_t*)(wl + O_WFO); E.mode = 6; E.PERM = true; E.fuse = canfuse && l == 0; }
    pg8::StaticOrder S; S.init(g.M, g.N, gridDim.x, (int)*(volatile LAS unsigned*)(LAS unsigned char*)(lds + LDS_BYTES - 8));
    pg8::gemm_phase((LAS unsigned char*)lds, g, S, E);
    const int c = S.c;
    if (gridDim.x == 256) {
        if (gi == 0 && c >= 224) { if (l == 0) conv_phase(p, lds, CV_PER_LAYER, CV_DEF_A, 0, 0, c - 224, 32); else conv_phase(p, lds, CV_PER_LAYER + CV_DEF_C, CV_DEF_D - CV_DEF_C, 0, 0, c - 224, 32); }
        if (gi == 3 && c >= 128) { if (l == 0) conv_phase(p, lds, CV_PER_LAYER + CV_DEF_A, CV_DEF_B - CV_DEF_A, 0, 0, c - 128, 128); else conv_phase(p, lds, CV_PER_LAYER + CV_DEF_D, CV_PER_LAYER - CV_DEF_D, 0, 0, c - 128, 128); }
    } else if (bidx() == 0 && (gi == 0 || gi == 3)) {
        if (gi == 0) { if (l == 0) conv_phase(p, lds, CV_PER_LAYER, CV_DEF_A, 0, 0, 0, 1); else conv_phase(p, lds, CV_PER_LAYER + CV_DEF_C, CV_DEF_D - CV_DEF_C, 0, 0, 0, 1); }
        else { if (l == 0) conv_phase(p, lds, CV_PER_LAYER + CV_DEF_A, CV_DEF_B - CV_DEF_A, 0, 0, 0, 1); else conv_phase(p, lds, CV_PER_LAYER + CV_DEF_D, CV_PER_LAYER - CV_DEF_D, 0, 0, 0, 1); }
    }
}

__device__ __forceinline__ void run_phase(const Params& p0, int ph, unsigned char* lds) {
    Params p = p0; asm volatile("" : "+s"(p.ws));
    const int G = gridDim.x, bid = bidx();
    if (ph == 0) {
        for (int it = bid; it < 256; it += G) mod_item(p, it, lds);
        conv_phase(p, lds, 0, CV_PER_LAYER, CV_PER_LAYER + CV_DEF_B, CV_DEF_C - CV_DEF_B, bid, G);
        return;
    }
    const int l = (ph - 1) / PH_PER_LAYER, q = (ph - 1) % PH_PER_LAYER;
    const float* MOD = (const float*)(p.ws + W_MOD) + l * 12288;
    float* X = (float*)(p.ws + W_X);
    const float* xin = l == 0 ? p.in[0] : X;
    bf16_t* H = (bf16_t*)(p.ws + W_H);
    int g0 = 0, g1 = -1;
    switch (q) {
    case 0: norm_phase(xin, p.in[4] + l * D, MOD, MOD + 2048, H); break;
    case 1: g0 = 0; g1 = 0; break;
    case 2:
        {
            const int c = (int)*(volatile LAS unsigned*)(LAS unsigned char*)(lds + LDS_BYTES - 8);
            const int vb = G == 256 ? (c & 7) * 32 + (c >> 3) : bid;
            for (int it = vb; it < 1280; it += G) { if (it < 384) sb_item(p, it, l, lds); else if (it < 768) dil_item(p, it - 384, l, lds); else gla1_item(p, it - 768, l, lds); }
        }
        break;
    case 3: gla2_phase(p); break;
    case 4:
        for (int it = bid; it < 512; it += G) gla3_item(p, it, l, lds);
        dilmix_phase(p);
        break;
    case 5: g0 = 1; g1 = 1; break;
    case 6: g0 = 2; g1 = 2; break;
    case 7: norm_phase(X, p.in[5] + l * D, MOD + 6144, MOD + 8192, H); break;
    case 8: g0 = 3; g1 = 3; break;
    case 9: g0 = 4; g1 = 4; break;
    }
#pragma unroll 1
    for (int gi = g0; gi <= g1; ++gi) { __syncthreads(); gemm_job(p, l, gi, lds); }
}

__global__ void __launch_bounds__(512, 2) fwd_megakernel(Params p) {
    extern __shared__ __attribute__((aligned(16))) unsigned char lds[];
    cg::grid_group grid = cg::this_grid();
    volatile LAS unsigned* st = (volatile LAS unsigned*)(LAS unsigned char*)(lds + LDS_BYTES - 16);
    if (threadIdx.x == 0) { st[0] = 0u; st[1] = 0u; st[2] = blockIdx.x; }
    __syncthreads();
    const XcdBarrier xb = xcd_barrier_post((unsigned*)(p.ws + W_BAR), st);
    if (p.ph_lo < 0) grid.sync();
#define GSYNC(ph) xcd_barrier(xb)
    for (int ph = p.ph_lo; ph < p.ph_hi; ++ph) {
        if (gridDim.x == 256 && ph >= 1) {
            const int l = (ph - 1) / PH_PER_LAYER, q = (ph - 1) % PH_PER_LAYER;
            if (q == 7 || (q == 0 && l == 1)) continue;
        }
        run_phase(p, ph, lds);
        if (ph + 1 < p.ph_hi) GSYNC(ph);
        if (ph == 0) {
            if (threadIdx.x == 0) {
                unsigned* bar = (unsigned*)(p.ws + W_BAR); bool ok = (gridDim.x & 7u) == 0u;
                for (unsigned j = 0; j < 16; ++j) { const unsigned c = xb_ld(&bar[XB_XCNT(j)]); ok = ok && (c == (j < 8 ? gridDim.x / 8u : 0u)); }
                if (ok) st[2] = st[3] * 8u + xb.x;
            }
            __syncthreads();
        }
    }
}

extern "C" void kernel_launch(void* const* d_in, const int* in_sizes, int n_in, void* d_out, int out_size, void* d_ws, size_t ws_size, hipStream_t stream) {
    static int grid_blocks = 0;
    if (!grid_blocks) {
        int dev = 0, cus = 0, per_cu = 0;
        hipGetDevice(&dev);
        hipDeviceGetAttribute(&cus, hipDeviceAttributeMultiprocessorCount, dev);
        hipFuncSetAttribute((const void*)fwd_megakernel, hipFuncAttributeMaxDynamicSharedMemorySize, LDS_BYTES);
        hipOccupancyMaxActiveBlocksPerMultiprocessor(&per_cu, (const void*)fwd_megakernel, 512, LDS_BYTES);
        if (per_cu < 1) { fprintf(stderr, "kernel_launch: occupancy query says %d blocks per CU\n", per_cu); per_cu = 1; }
        (void)hipGetLastError();
        grid_blocks = cus * per_cu;
        if (ws_size < W_END) { fprintf(stderr, "kernel_launch: workspace too small: %zu < %zu; nothing launched\n", ws_size, (size_t)W_END); grid_blocks = -1; }
    }
    if (grid_blocks < 0) return;
    Params p{};
    for (int i = 0; i < 20; ++i) p.in[i] = (const float*)d_in[i];
    p.out = (float*)d_out; p.ws = (unsigned char*)d_ws; p.ph_lo = 0; p.ph_hi = N_PHASES;
    (void)hipMemsetAsync((unsigned char*)d_ws + W_BAR, 0, 16384 + 3 * 32 * 256, stream);
    void* args[] = {&p};
    hipError_t e = hipLaunchCooperativeKernel((const void*)fwd_megakernel, dim3(grid_blocks), dim3(512), args, LDS_BYTES, stream);
    if (e != hipSuccess) fprintf(stderr, "cooperative launch failed: %s (grid %d)\n", hipGetErrorString(e), grid_blocks);
}
```
